# Optimizing an MI355X kernel written in HIP

```python
import math
import jax
import jax.numpy as jnp
from jax import lax
import numpy as np

D_MODEL = 1024
BATCH = 2
SEQ = 8192
DEPTH = 4

HEAD_DIM = 64
GROUP_HEADS = 4
GROUP_WIDTH = GROUP_HEADS * HEAD_DIM
D_MIX = 4 * GROUP_WIDTH
GLA_RANK = 16
GLA_TAU = 16.0
GLA_CHUNK = 64
GRID_W = 64
NA_ROWS_MAX = 8
NA_COLS = 16
LRU_CONV = 4
LRU_CONV_LEFT = 2
LRU_C = 8.0
DIL_PAIRS = ((128, 1), (512, 4), (2048, 16))
ROPE_THETA = 10000.0
D_FF = -(-8 * D_MODEL // (3 * 256)) * 256
EPS = 1e-6
SPLITS = (GROUP_WIDTH,) * 4 + (2 * GLA_RANK,) + (GROUP_WIDTH,) * 3 + (GROUP_WIDTH,) * 2 + (GROUP_WIDTH,) * 3
D_IN = sum(SPLITS)

kernel_name = "hybrid_parallel_head_group_encoder"


def rmsnorm(x, g):
    xf = x.astype(jnp.float32)
    y = xf * lax.rsqrt(jnp.mean(xf * xf, axis=-1, keepdims=True) + EPS)
    return (y * g.astype(jnp.float32)).astype(x.dtype)


def to_heads(t):
    B, L, _ = t.shape
    return t.reshape(B, L, -1, HEAD_DIM).transpose(0, 2, 1, 3)


def from_heads(t):
    B, H, L, dh = t.shape
    return t.transpose(0, 2, 1, 3).reshape(B, L, H * dh)


def rope(t, cos, sin):
    t1, t2 = jnp.split(t, 2, axis=-1)
    c = cos.astype(t.dtype)
    s = sin.astype(t.dtype)
    return jnp.concatenate([t1 * c - t2 * s, t2 * c + t1 * s], axis=-1)


def gla_chunked(q, k, v, log_a):
    B, H, L, dk = q.shape
    dv = v.shape[-1]
    C = GLA_CHUNK
    n = L // C
    q, k, v, log_a = [t.reshape(B, H, n, C, -1) for t in (q, k, v, log_a)]
    b = jnp.cumsum(log_a, axis=3)
    b_last = b[:, :, :, C - 1:C, :]
    b_mid = b[:, :, :, C // 2 - 1:C // 2, :]
    att = jnp.einsum('bhnck,bhnsk->bhncs', q * jnp.exp(b - b_mid), k * jnp.exp(b_mid - b))
    tri = np.tril(np.ones((C, C), dtype=bool))
    att = jnp.where(tri, att, 0.0)
    o_intra = jnp.einsum('bhncs,bhnsv->bhncv', att, v)
    chunk_kv = jnp.einsum('bhnck,bhncv->bhnkv', k * jnp.exp(b_last - b), v)
    decay = jnp.exp(b_last[:, :, :, 0, :])

    def step(S, inp):
        kv_c, d_c = inp
        return S * d_c[..., None] + kv_c, S

    S0 = jnp.zeros((B, H, dk, dv), jnp.float32)
    _, S_prev = lax.scan(step, S0, (jnp.moveaxis(chunk_kv, 2, 0), jnp.moveaxis(decay, 2, 0)))
    S_prev = jnp.moveaxis(S_prev, 0, 2)
    o_inter = jnp.einsum('bhnck,bhnkv->bhncv', q * jnp.exp(b), S_prev)
    return (o_intra + o_inter).reshape(B, H, L, dv)


def gla_mixer(q, k, v, g, z, w_gate, b_gate, norm_g):
    B, L, _ = q.shape
    f32 = jnp.float32
    zl = z.astype(f32).reshape(B, L, 2, GLA_RANK)
    logit = jnp.einsum('bler,erc->eblc', zl, w_gate.astype(f32)) + b_gate.astype(f32)[:, None, None, :]
    log_a = jax.nn.log_sigmoid(logit) / GLA_TAU
    qh = to_heads(q).astype(f32) * (HEAD_DIM ** -0.5)
    kh = to_heads(k).astype(f32)
    vh = to_heads(v).astype(f32)
    flip = lambda t: jnp.flip(t, axis=2)
    o_f = gla_chunked(qh, kh, vh, to_heads(log_a[0]))
    o_b = flip(gla_chunked(flip(qh), flip(kh), flip(vh), flip(to_heads(log_a[1]))))
    o = o_f + o_b
    o = o * lax.rsqrt(jnp.mean(o * o, axis=-1, keepdims=True) + EPS)
    o = o * norm_g.astype(f32).reshape(GROUP_HEADS, 1, HEAD_DIM)
    return (from_heads(o) * jax.nn.silu(g.astype(f32))).astype(q.dtype)


def neighbourhood_attention(q, k, v, rpb):
    B, H, L, dh = q.shape
    rows = L // GRID_W
    kr = min(NA_ROWS_MAX, rows)
    grid = lambda t: t.reshape(B, H, rows, GRID_W, dh)
    qg, kg, vg = grid(q), grid(k), grid(v)
    r = np.arange(rows)
    row_idx = np.clip(r - kr // 2, 0, rows - kr)[:, None] + np.arange(kr)[None, :]
    k_rows = kg[:, :, row_idx]
    v_rows = vg[:, :, row_idx]
    c = np.arange(GRID_W)
    col_start = np.clip(c - NA_COLS // 2, 0, GRID_W - NA_COLS)
    col_ok = (c[None, :] >= col_start[:, None]) & (c[None, :] < col_start[:, None] + NA_COLS)
    dr = row_idx - r[:, None]
    dc = np.clip(c[None, :] - c[:, None], -(NA_COLS - 1), NA_COLS - 1)
    bias = rpb[:, (dr + NA_ROWS_MAX - 1)[:, None, :, None], (dc + NA_COLS - 1)[None, :, None, :]]
    s = jnp.einsum('bhrqd,bhrikd->bhrqik', qg, k_rows).astype(jnp.float32) * (dh ** -0.5)
    s = s + bias.astype(jnp.float32)
    s = jnp.where(col_ok[:, None, :], s, -jnp.inf)
    p = jax.nn.softmax(s.reshape(B, H, rows, GRID_W, kr * GRID_W), axis=-1).reshape(s.shape)
    o = jnp.einsum('bhrqik,bhrikd->bhrqd', p.astype(v.dtype), v_rows)
    return o.reshape(B, H, L, dh)


def linear_scan(a, u):
    def combine(left, right):
        a_l, u_l = left
        a_r, u_r = right
        return a_l * a_r, a_r * u_l + u_r
    return lax.associative_scan(combine, (a, u), axis=1)[1]


def rglru_mixer(xb, gate, conv_w, conv_b, w_a, b_a, w_x, b_x, lam):
    B, L, C = xb.shape
    f32 = jnp.float32
    xp = jnp.pad(xb.astype(f32), ((0, 0), (LRU_CONV_LEFT, LRU_CONV - 1 - LRU_CONV_LEFT), (0, 0)))
    xc = conv_b.astype(f32)
    for j in range(LRU_CONV):
        xc = xc + xp[:, j:j + L, :] * conv_w[j].astype(f32)
    xh = xc.reshape(B, L, GROUP_HEADS, HEAD_DIM)
    r = jax.nn.sigmoid(jnp.einsum('blhi,ehij->eblhj', xh, w_a.astype(f32)).reshape(2, B, L, C)
                       + b_a.astype(f32)[:, None, None, :])
    i = jax.nn.sigmoid(jnp.einsum('blhi,ehij->eblhj', xh, w_x.astype(f32)).reshape(2, B, L, C)
                       + b_x.astype(f32)[:, None, None, :])
    log_a = -LRU_C * r * jax.nn.softplus(-lam.astype(f32))[:, None, None, :]
    a = jnp.exp(log_a)
    u = jnp.sqrt(-jnp.expm1(2.0 * log_a)) * (i * xc[None])
    flip = lambda t: jnp.flip(t, axis=1)
    h = linear_scan(a[0], u[0]) + flip(linear_scan(flip(a[1]), flip(u[1])))
    return (h * jax.nn.gelu(gate.astype(f32))).astype(xb.dtype)


def band_attention(q, k, v, radius):
    lead = q.shape[:-2]
    n, dh = q.shape[-2], q.shape[-1]
    Q = radius
    nb = -(-n // Q)
    n_pad = nb * Q
    nl = len(lead)
    qb = jnp.pad(q, ((0, 0),) * nl + ((0, n_pad - n), (0, 0))).reshape(lead + (nb, Q, dh))
    padkv = lambda t: jnp.pad(t, ((0, 0),) * nl + ((Q, n_pad - n + Q), (0, 0))).reshape(lead + (nb + 2, Q, dh))
    kp, vp = padkv(k), padkv(v)
    band = lambda t: jnp.concatenate([t[..., 0:nb, :, :], t[..., 1:nb + 1, :, :], t[..., 2:nb + 2, :, :]], axis=-2)
    kb, vb = band(kp), band(vp)
    blk = np.arange(nb)[:, None, None]
    qpos = blk * Q + np.arange(Q)[None, :, None]
    kpos = blk * Q + np.arange(3 * Q)[None, None, :] - Q
    valid = (np.abs(kpos - qpos) <= radius) & (kpos >= 0) & (kpos < n)
    s = jnp.einsum('...bqd,...bkd->...bqk', qb, kb).astype(jnp.float32) * (dh ** -0.5)
    s = jnp.where(valid, s, -jnp.inf)
    m = jnp.max(s, axis=-1, keepdims=True)
    e = jnp.exp(s - m)
    den = jnp.sum(e, axis=-1, keepdims=True)
    o = jnp.einsum('...bqk,...bkd->...bqd', (e / den).astype(v.dtype), vb)
    lse = (m + jnp.log(den))[..., 0]
    o = o.reshape(lead + (n_pad, dh))[..., :n, :]
    lse = lse.reshape(lead + (n_pad,))[..., :n]
    return o, lse


def dilated_attention(q, k, v):
    B, H, L, dh = q.shape
    outs, lses = [], []
    for window, dil in DIL_PAIRS:
        radius = window // (2 * dil)
        n = L // dil
        sub = lambda t: t.reshape(B, H, n, dil, dh).transpose(0, 1, 3, 2, 4)
        o, lse = band_attention(sub(q), sub(k), sub(v), radius)
        outs.append(o.transpose(0, 1, 3, 2, 4).reshape(B, H, L, dh).astype(jnp.float32))
        lses.append(lse.transpose(0, 1, 3, 2).reshape(B, H, L))
    wts = jax.nn.softmax(jnp.stack(lses, axis=0), axis=0)
    return jnp.einsum('gbhl,gbhld->bhld', wts, jnp.stack(outs, axis=0)).astype(q.dtype)


def setup_inputs(seed: int = 0) -> dict:
    key = jax.random.key(seed)
    ks = jax.random.split(key, 24)
    f32 = jnp.float32
    nrm = lambda k, shape, scale: scale * jax.random.normal(k, shape, f32)
    gain = lambda k, d: 1.0 + 0.02 * jax.random.normal(k, (DEPTH, d), f32)
    u = jax.random.uniform(ks[14], (DEPTH, 2, GROUP_WIDTH), f32, 0.9, 0.999)
    return {
        "x": jax.random.normal(ks[0], (BATCH, SEQ, D_MODEL), f32),
        "mix_norm_pre": gain(ks[1], D_MODEL),
        "mix_norm_post": gain(ks[2], D_MODEL),
        "w_in": nrm(ks[3], (DEPTH, D_MODEL, D_IN), D_MODEL ** -0.5),
        "gla_w_gate": nrm(ks[4], (DEPTH, 2, GLA_RANK, GROUP_WIDTH), GLA_RANK ** -0.5),
        "gla_b_gate": nrm(ks[5], (DEPTH, 2, GROUP_WIDTH), 0.1),
        "gla_norm": gain(ks[6], GROUP_WIDTH),
        "na_rpb": nrm(ks[7], (DEPTH, GROUP_HEADS, 2 * NA_ROWS_MAX - 1, 2 * NA_COLS - 1), 0.1),
        "lru_conv_w": nrm(ks[8], (DEPTH, LRU_CONV, GROUP_WIDTH), LRU_CONV ** -0.5),
        "lru_conv_b": nrm(ks[9], (DEPTH, GROUP_WIDTH), 0.02),
        "lru_w_a": nrm(ks[10], (DEPTH, 2, GROUP_HEADS, HEAD_DIM, HEAD_DIM), HEAD_DIM ** -0.5),
        "lru_b_a": nrm(ks[11], (DEPTH, 2, GROUP_WIDTH), 0.1),
        "lru_w_x": nrm(ks[12], (DEPTH, 2, GROUP_HEADS, HEAD_DIM, HEAD_DIM), HEAD_DIM ** -0.5),
        "lru_b_x": nrm(ks[13], (DEPTH, 2, GROUP_WIDTH), 0.1),
        "lru_lambda": jnp.log(u) - jnp.log1p(-u),
        "w_out": nrm(ks[15], (DEPTH, D_MIX, D_MODEL), D_MIX ** -0.5),
        "ffn_norm_pre": gain(ks[16], D_MODEL),
        "ffn_norm_post": gain(ks[17], D_MODEL),
        "ffn_w_in": nrm(ks[18], (DEPTH, D_MODEL, 2 * D_FF), D_MODEL ** -0.5),
        "ffn_w_out": nrm(ks[19], (DEPTH, D_FF, D_MODEL), D_FF ** -0.5),
    }


def reference(x, mix_norm_pre, mix_norm_post, w_in, gla_w_gate, gla_b_gate, gla_norm, na_rpb,
              lru_conv_w, lru_conv_b, lru_w_a, lru_b_a, lru_w_x, lru_b_x, lru_lambda, w_out,
              ffn_norm_pre, ffn_norm_post, ffn_w_in, ffn_w_out):
    B, L, _ = x.shape
    pos = jnp.arange(L, dtype=jnp.float32)
    inv_freq = ROPE_THETA ** (-jnp.arange(0, HEAD_DIM, 2, dtype=jnp.float32) / HEAD_DIM)
    ang = pos[:, None] * inv_freq[None, :]
    cos, sin = jnp.cos(ang), jnp.sin(ang)
    split_at = [int(s) for s in np.cumsum(SPLITS)[:-1]]
    for l in range(DEPTH):
        h = rmsnorm(x, mix_norm_pre[l])
        p = h @ w_in[l]
        qa, ka, va, ga, za, qb, kb, vb, xc, gc, qd, kd, vd = jnp.split(p, split_at, axis=-1)
        ya = gla_mixer(qa, ka, va, ga, za, gla_w_gate[l], gla_b_gate[l], gla_norm[l])
        yb = from_heads(neighbourhood_attention(to_heads(qb), to_heads(kb), to_heads(vb), na_rpb[l]))
        yc = rglru_mixer(xc, gc, lru_conv_w[l], lru_conv_b[l], lru_w_a[l], lru_b_a[l],
                         lru_w_x[l], lru_b_x[l], lru_lambda[l])
        yd = from_heads(dilated_attention(rope(to_heads(qd), cos, sin), rope(to_heads(kd), cos, sin),
                                          to_heads(vd)))
        y = jnp.concatenate([ya, yb.astype(x.dtype), yc, yd.astype(x.dtype)], axis=-1) @ w_out[l]
        x = x + rmsnorm(y, mix_norm_post[l])
        h = rmsnorm(x, ffn_norm_pre[l])
        gate, up = jnp.split(h @ ffn_w_in[l], 2, axis=-1)
        f = (jax.nn.silu(gate) * up) @ ffn_w_out[l]
        x = x + rmsnorm(f, ffn_norm_post[l])
    return x
```

```cpp
#include <hip/hip_runtime.h>
#include <hip/hip_cooperative_groups.h>
#include <cstdio>
#include <cstdint>
namespace cg = cooperative_groups;
namespace pg8 {
#define PG8_LAS __attribute__((address_space(3)))
typedef unsigned short bf16_t;
typedef short bf16x8 __attribute__((ext_vector_type(8)));
typedef float f32x4 __attribute__((ext_vector_type(4)));
typedef unsigned u32x4 __attribute__((ext_vector_type(4)));
constexpr int BM = 256, BK = 64, HALF = 128, HTB = HALF * BK * 2  , STAGE_BYTES = 8 * HTB, NXCD = 8, WGM = 8;

__host__ __device__ __forceinline__ int lds_byte(int r, int c) { const int st = (r >> 4) * 2 + (c >> 5), rr = r & 15, cc = c & 31, ob = rr * 64 + cc * 2; return st * 1024 + (ob ^ (((ob >> 9) & 1) << 5)); }
__host__ __device__ __forceinline__ void stage_rc(int b, int& R, int& C) { const int st = b / 1024, sb = b % 1024, swz = sb ^ (((sb >> 9) & 1) << 5); R = (st >> 1) * 16 + swz / 64; C = (st & 1) * 32 + (swz % 64) / 2; }
__host__ __device__ __forceinline__ int perm32(int rho) { const int n = rho >> 4, i = rho & 15; return 8 * (i >> 2) + 4 * n + (i & 3); }

struct Unit { int pm, pn; };
struct Gemm { const bf16_t* A; const bf16_t* Bt; int M, N, K; };

struct StaticOrder {
    int nM, nN, nwg, G, c;
    __host__ __device__ void init(int M, int N, int G_, int c_) { nM = M / BM; nN = N / BM; nwg = nM * nN; G = G_; c = c_; }
    __host__ __device__ bool next(int i, Unit& u) const {
        const long L = (long)i * G + c; if (L >= nwg) return false;
        int wgid = (int)L; { const int q = nwg / NXCD, r = nwg % NXCD, xcd = wgid % NXCD, off = wgid / NXCD; wgid = (xcd < r ? xcd * (q + 1) : r * (q + 1) + (xcd - r) * q) + off; }
        const int nig = WGM * nN, gid = wgid / nig, fm = gid * WGM, gsz = (nM - fm) < WGM ? (nM - fm) : WGM;
        u.pm = fm + ((wgid % nig) % gsz); u.pn = (wgid % nig) / gsz; return true;
    }
    __device__ __forceinline__ void a_ready(const Unit&) const {}
    __device__ __forceinline__ void done(const Unit&) const {}
};

__device__ __forceinline__ unsigned cvt_pk_bf16(float lo, float hi) { unsigned r; asm volatile("v_cvt_pk_bf16_f32 %0, %1, %2" : "=v"(r) : "v"(lo), "v"(hi)); return r; }
template <class Epi, class Sched, bool ALIGN_EPI = false, bool SP2 = false>
__device__ __forceinline__ void gemm_phase(PG8_LAS unsigned char* lds, const Gemm g, const Sched& S, const Epi& E, const int tid) {
    const int wid = __builtin_amdgcn_readfirstlane(tid >> 6), lane = tid & 63, wr = wid >> 2, wc = wid & 3, fr = lane & 15, fq = lane >> 4;
    const int K = g.K, nt = K / BK;
    unsigned voffA[2], voffB[2];
#pragma unroll
    for (int i = 0; i < 2; ++i) { int R, C; stage_rc(tid * 16 + i * 8192, R, C); const int Rb = Epi::PERM ? ((R & ~31) + perm32(R & 31)) : R;
        voffA[i] = (unsigned)(R * K + C) * 2u; voffB[i] = (unsigned)(Rb * K + C) * 2u; }
    const size_t kstep = (size_t)(BK * 2);
    const size_t hstep = (size_t)HALF * K * 2;
    const size_t tstep = 2 * hstep;
    const unsigned ldsw = (unsigned)wid * 1024u;
    const int aoff = lds_byte(wr * 64 + fr, fq * 8), boff = lds_byte(wc * 32 + fr, fq * 8);
#define PG8_SA(b, h) (((b) * 2 + (h)) * HTB)
#define PG8_SB(b, h) ((4 + (b) * 2 + (h)) * HTB)
#define PG8_STAGE(bufoff, gbase, voff) do { _Pragma("unroll") for (int _i = 0; _i < 2; ++_i) \
        __builtin_amdgcn_global_load_lds((const unsigned*)((const char*)(gbase) + (voff)[_i]), (PG8_LAS unsigned*)(lds + (bufoff) + ldsw + _i * 8192), 16, 0, 0); } while (0)
#define PG8_LDA(dst, b, h) do { _Pragma("unroll") for (int m = 0; m < 4; ++m) _Pragma("unroll") for (int k = 0; k < 2; ++k) dst[m][k] = *(const PG8_LAS bf16x8*)(lds + PG8_SA(b, h) + aoff + m * 2048 + k * 1024); } while (0)
#define PG8_LDB(dst, b, h) do { _Pragma("unroll") for (int n = 0; n < 2; ++n) _Pragma("unroll") for (int k = 0; k < 2; ++k) dst[n][k] = *(const PG8_LAS bf16x8*)(lds + PG8_SB(b, h) + boff + n * 2048 + k * 1024); } while (0)
#define PG8_MMA(ai, bj, At, Bt) do { __builtin_amdgcn_s_setprio(1); _Pragma("unroll") for (int m = 0; m < 4; ++m) _Pragma("unroll") for (int n = 0; n < 2; ++n) _Pragma("unroll") for (int k = 0; k < 2; ++k) \
        acc[ai][bj][m][n] = __builtin_amdgcn_mfma_f32_16x16x32_bf16(Bt[n][k], At[m][k], acc[ai][bj][m][n], 0, 0, 0); __builtin_amdgcn_s_setprio(0); } while (0)
#define PG8_WAIT_V(n) asm volatile("s_waitcnt vmcnt(" #n ")" ::: "memory")
#define PG8_WAIT_L(n) asm volatile("s_waitcnt lgkmcnt(" #n ")" ::: "memory")
#define PG8_BAR __builtin_amdgcn_s_barrier()
#define PG8_SCHED __builtin_amdgcn_sched_barrier(0)
    Unit cur, nxt; int ui = 0;
    if (!S.next(0, cur)) return;
    f32x4 acc[2][2][4][2];
#pragma unroll
    for (int a = 0; a < 2; ++a)
#pragma unroll
        for (int b = 0; b < 2; ++b)
#pragma unroll
            for (int m = 0; m < 4; ++m)
#pragma unroll
                for (int n = 0; n < 2; ++n) acc[a][b][m][n] = (f32x4){0.f, 0.f, 0.f, 0.f};
    bf16x8 At[4][2], B0[2][2], B1[2][2];
    const char* cA = (const char*)g.A + (size_t)cur.pm * tstep; const char* cB = (const char*)g.Bt + (size_t)cur.pn * tstep;
    S.a_ready(cur);
    if constexpr (SP2) {
        PG8_STAGE(PG8_SB(0, 0), cB, voffB); PG8_STAGE(PG8_SB(0, 1), cB + hstep, voffB); PG8_STAGE(PG8_SA(0, 0), cA, voffA); PG8_STAGE(PG8_SA(0, 1), cA + hstep, voffA);
        if (wr == 1) PG8_BAR;
        PG8_WAIT_V(2); PG8_BAR;
        PG8_STAGE(PG8_SB(1, 0), cB + kstep, voffB); PG8_STAGE(PG8_SA(1, 0), cA + kstep, voffA); PG8_STAGE(PG8_SB(1, 1), cB + hstep + kstep, voffB);
        PG8_WAIT_V(6); PG8_BAR;
    } else {
        PG8_STAGE(PG8_SB(0, 0), cB, voffB); PG8_STAGE(PG8_SA(0, 0), cA, voffA); PG8_STAGE(PG8_SB(0, 1), cB + hstep, voffB); PG8_STAGE(PG8_SA(0, 1), cA + hstep, voffA);
        if (wr == 1) PG8_BAR;
        PG8_WAIT_V(4); PG8_BAR;
        PG8_STAGE(PG8_SB(1, 0), cB + kstep, voffB); PG8_STAGE(PG8_SA(1, 0), cA + kstep, voffA); PG8_STAGE(PG8_SB(1, 1), cB + hstep + kstep, voffB);
        PG8_WAIT_V(6); PG8_BAR;
    }
    for (;;) {
        const bool has_next = S.next(ui + 1, nxt);
        const char* nA = has_next ? (const char*)g.A + (size_t)nxt.pm * tstep : cA; const char* nB = has_next ? (const char*)g.Bt + (size_t)nxt.pn * tstep : cB;
        for (int t = 0; t < nt; t += 2) {
            const bool last = (t == nt - 2);
            const char* a1 = cA + (size_t)(t + 1) * kstep;
            const char* a2 = last ? nA : cA + (size_t)(t + 2) * kstep; const char* b2 = last ? nB : cB + (size_t)(t + 2) * kstep;
            const char* a3 = a2 + kstep; const char* b3 = b2 + kstep;
            if (last && has_next) S.a_ready(nxt);
            if constexpr (SP2) {
            PG8_LDB(B0, 0, 0); PG8_LDB(B1, 0, 1); PG8_SCHED; PG8_LDA(At, 0, 0); PG8_STAGE(PG8_SA(1, 1), a1 + hstep, voffA);
            PG8_WAIT_V(8); PG8_WAIT_L(0); PG8_BAR; PG8_MMA(0, 0, At, B0); PG8_MMA(0, 1, At, B1); PG8_BAR; PG8_SCHED;
            PG8_LDA(At, 0, 1); PG8_STAGE(PG8_SB(0, 0), b2, voffB); PG8_STAGE(PG8_SB(0, 1), b2 + hstep, voffB); PG8_STAGE(PG8_SA(0, 0), a2, voffA);
            PG8_WAIT_V(8); PG8_WAIT_L(0); PG8_BAR; PG8_MMA(1, 0, At, B0); PG8_MMA(1, 1, At, B1); PG8_BAR; PG8_SCHED;
            PG8_LDB(B0, 1, 0); PG8_LDB(B1, 1, 1); PG8_SCHED; PG8_LDA(At, 1, 0); PG8_STAGE(PG8_SA(0, 1), a2 + hstep, voffA);
            PG8_WAIT_V(8); PG8_WAIT_L(0); PG8_BAR; PG8_MMA(0, 0, At, B0); PG8_MMA(0, 1, At, B1); PG8_BAR; PG8_SCHED;
            PG8_LDA(At, 1, 1); PG8_STAGE(PG8_SB(1, 0), b3, voffB); PG8_STAGE(PG8_SB(1, 1), b3 + hstep, voffB); PG8_STAGE(PG8_SA(1, 0), a3, voffA);
            PG8_WAIT_V(8); PG8_WAIT_L(0); PG8_BAR; PG8_MMA(1, 0, At, B0); PG8_MMA(1, 1, At, B1); PG8_BAR; PG8_SCHED;
            } else {
            PG8_LDB(B0, 0, 0); PG8_SCHED; PG8_LDA(At, 0, 0); PG8_STAGE(PG8_SA(1, 1), a1 + hstep, voffA);
            PG8_WAIT_L(8); PG8_BAR; PG8_WAIT_L(0); PG8_MMA(0, 0, At, B0); PG8_BAR; PG8_SCHED;
            PG8_LDB(B1, 0, 1); PG8_STAGE(PG8_SB(0, 0), b2, voffB);
            PG8_BAR; PG8_WAIT_L(0); PG8_MMA(0, 1, At, B1); PG8_BAR;
            PG8_LDA(At, 0, 1); PG8_STAGE(PG8_SA(0, 0), a2, voffA);
            PG8_BAR; PG8_WAIT_L(0); PG8_MMA(1, 0, At, B0); PG8_BAR; PG8_SCHED;
            PG8_STAGE(PG8_SB(0, 1), b2 + hstep, voffB);
            PG8_WAIT_V(6); PG8_BAR; PG8_MMA(1, 1, At, B1); PG8_BAR;
            PG8_LDB(B0, 1, 0); PG8_SCHED; PG8_LDA(At, 1, 0); PG8_STAGE(PG8_SA(0, 1), a2 + hstep, voffA);
            PG8_WAIT_L(8); PG8_BAR; PG8_WAIT_L(0); PG8_MMA(0, 0, At, B0); PG8_BAR; PG8_SCHED;
            PG8_LDB(B1, 1, 1); PG8_STAGE(PG8_SB(1, 0), b3, voffB);
            PG8_BAR; PG8_WAIT_L(0); PG8_MMA(0, 1, At, B1); PG8_BAR;
            PG8_LDA(At, 1, 1); PG8_STAGE(PG8_SA(1, 0), a3, voffA);
            PG8_BAR; PG8_WAIT_L(0); PG8_MMA(1, 0, At, B0); PG8_BAR; PG8_SCHED;
            PG8_STAGE(PG8_SB(1, 1), b3 + hstep, voffB);
            PG8_WAIT_V(6); PG8_BAR; PG8_MMA(1, 1, At, B1); PG8_BAR;
            }
        }
        if constexpr (ALIGN_EPI) { if (wr == 0) PG8_BAR; }
        if constexpr (!Epi::AFTER_DRAIN) { E(acc, cur, wr, wc, fr, fq); S.done(cur); }
        if (!has_next) break;
#pragma unroll
        for (int a = 0; a < 2; ++a)
#pragma unroll
            for (int b = 0; b < 2; ++b)
#pragma unroll
                for (int m = 0; m < 4; ++m)
#pragma unroll
                    for (int n = 0; n < 2; ++n) acc[a][b][m][n] = (f32x4){0.f, 0.f, 0.f, 0.f};
        cur = nxt; cA = nA; cB = nB; ++ui;
        if constexpr (ALIGN_EPI) { if (wr == 1) PG8_BAR; }
    }
    PG8_WAIT_V(0);
    if constexpr (!ALIGN_EPI) { if (wr == 0) PG8_BAR; }
    PG8_BAR;
    if constexpr (Epi::AFTER_DRAIN) { E.fused(acc, cur, wr, wc, fr, fq, lds, wid, lane); S.done(cur); }
#undef PG8_SA
#undef PG8_SB
#undef PG8_STAGE
#undef PG8_LDA
#undef PG8_LDB
#undef PG8_MMA
#undef PG8_WAIT_V
#undef PG8_WAIT_L
#undef PG8_BAR
#undef PG8_SCHED
}
}

namespace pg8 {
struct EpiStore {
    static constexpr bool PERM = true, AFTER_DRAIN = false;
    bf16_t* O; int ldc; int ncols; int shift_from, shift;
    __device__ __forceinline__ void operator()(const f32x4 (&acc)[2][2][4][2], const Unit& u, int wr, int wc, int fr, int fq) const {
        const int row0 = u.pm * BM + wr * 64 + fr; const int col0 = u.pn * BM + wc * 32 + 8 * fq;
#pragma unroll
        for (int ai = 0; ai < 2; ++ai)
#pragma unroll
            for (int m = 0; m < 4; ++m) { bf16_t* rowp = O + (size_t)(row0 + ai * HALF + m * 16) * ldc;
#pragma unroll
                for (int bj = 0; bj < 2; ++bj) { const int col = col0 + bj * HALF;
                    if (col < ncols) { const f32x4 v0 = acc[ai][bj][m][0], v1 = acc[ai][bj][m][1];
                        u32x4 w; w.x = cvt_pk_bf16(v0[0], v0[1]); w.y = cvt_pk_bf16(v0[2], v0[3]); w.z = cvt_pk_bf16(v1[0], v1[1]); w.w = cvt_pk_bf16(v1[2], v1[3]);
                        *(u32x4*)(rowp + col + (col >= shift_from ? shift : 0)) = w; } } }
    }
};
struct EpiSwiGLU {
    static constexpr bool PERM = true, AFTER_DRAIN = false;
    bf16_t* O; int ldc;
    __device__ __forceinline__ void operator()(const f32x4 (&acc)[2][2][4][2], const Unit& u, int wr, int wc, int fr, int fq) const {
        const int row0 = u.pm * BM + wr * 64 + fr; const int col0 = u.pn * BM + wc * 32 + 8 * fq;
#pragma unroll
        for (int ai = 0; ai < 2; ++ai)
#pragma unroll
            for (int m = 0; m < 4; ++m) { bf16_t* rowp = O + (size_t)(row0 + ai * HALF + m * 16) * ldc;
#pragma unroll
                for (int bj = 0; bj < 2; ++bj) { const int col = col0 + bj * HALF; const f32x4 g = acc[ai][bj][m][0], up = acc[ai][bj][m][1];
                    float r[4];
#pragma unroll
                    for (int i = 0; i < 4; ++i) r[i] = g[i] * __builtin_amdgcn_rcpf(1.f + __expf(-g[i])) * up[i];
                    uint2 w; w.x = cvt_pk_bf16(r[0], r[1]); w.y = cvt_pk_bf16(r[2], r[3]);
                    *(uint2*)(rowp + (col >> 1)) = w; } }
    }
};
}

constexpr int L_SEQ = 8192, NB = 2, MTOK = NB * L_SEQ, DM = 1024, DIN = 3104, DIN_PAD = 3328, DFF = 2816, DEPTH = 4;
constexpr int C_QA = 0, C_KA = 256, C_VA = 512, C_GA = 768, C_ZA = 1024, C_QB = 1056, C_XC = 1824, C_GC = 2080, C_QD = 2336;
constexpr float EPS = 1e-6f;
#define ZSPLIT 0
constexpr size_t A256(size_t x) { return (x + 255) & ~(size_t)255; }
constexpr size_t WS_CTL = 0, CTL_BYTES = 65536;
constexpr size_t WS_ROPE = CTL_BYTES;
constexpr size_t WS_LRUW = WS_ROPE + A256((size_t)L_SEQ * 32 * 8);
constexpr size_t WS_WIN  = WS_LRUW + A256((size_t)DEPTH * 2 * 2 * 4 * 4096 * 2);
constexpr size_t WS_WOUT = WS_WIN + (size_t)DEPTH * DIN_PAD * DM * 2;
constexpr size_t WS_WF1  = WS_WOUT + (size_t)DEPTH * DM * DM * 2;
constexpr size_t WS_WF2  = WS_WF1 + (size_t)DEPTH * 2 * DFF * DM * 2;
constexpr size_t WS_H    = WS_WF2 + (size_t)DEPTH * DM * DFF * 2;
constexpr size_t WS_P    = WS_H + (size_t)MTOK * DM * 2;
constexpr size_t WS_GLA  = WS_P + (size_t)MTOK * DIN * 2;
constexpr size_t WS_GDEC = WS_GLA + (size_t)2048 * 4096 * 4;
constexpr size_t WS_LRUA = WS_GDEC + (size_t)2048 * 64 * 4;
constexpr size_t WS_LRUH = WS_LRUA + (size_t)2 * 2 * 128 * 256 * 4;
constexpr size_t WS_DAP  = WS_LRUH + (size_t)2 * 2 * 128 * 256 * 4;
constexpr size_t WS_DAL  = WS_DAP + (size_t)3 * MTOK * 256 * 2;
constexpr size_t WS_GB   = WS_DAL + (size_t)3 * MTOK * 4 * 4;
constexpr size_t WS_END  = WS_GB + (size_t)2048 * 4096 * 4;

constexpr int LDS_BYTES = 147456;
constexpr int NTHR = 512;

typedef unsigned short u16;
typedef short bf16x8 __attribute__((ext_vector_type(8)));
typedef float f32x4 __attribute__((ext_vector_type(4)));
typedef unsigned u32x4 __attribute__((ext_vector_type(4)));

struct Params { const float* in[20]; float* out; unsigned char* ws; int ph_lo, ph_hi; };
typedef const Params __attribute__((address_space(4)))* PP;
__device__ __forceinline__ PP get_pp() { PP p = (PP)__builtin_amdgcn_kernarg_segment_ptr(); asm volatile("" : "+s"(p)); return p; }

__device__ __forceinline__ unsigned f2bf(float f) { unsigned u = __float_as_uint(f); return (u + 0x7fffu + ((u >> 16) & 1u)) >> 16; }
__device__ __forceinline__ float bf2f(unsigned h) { return __uint_as_float(h << 16); }
__device__ __forceinline__ unsigned pk2(float lo, float hi) { return f2bf(lo) | (f2bf(hi) << 16); }
__device__ __forceinline__ float blo(unsigned w) { return __uint_as_float(w << 16); }
__device__ __forceinline__ float bhi(unsigned w) { return __uint_as_float(w & 0xffff0000u); }
#define UNPACK8(v, f) do { f[0] = blo(v.x); f[1] = bhi(v.x); f[2] = blo(v.y); f[3] = bhi(v.y); f[4] = blo(v.z); f[5] = bhi(v.z); f[6] = blo(v.w); f[7] = bhi(v.w); } while (0)
#define PACK8(v, f) do { v.x = pk2(f[0], f[1]); v.y = pk2(f[2], f[3]); v.z = pk2(f[4], f[5]); v.w = pk2(f[6], f[7]); } while (0)
__device__ __forceinline__ f32x4 mfma16(bf16x8 a, bf16x8 b, f32x4 c) { return __builtin_amdgcn_mfma_f32_16x16x32_bf16(a, b, c, 0, 0, 0); }
__device__ __forceinline__ bf16x8 ldfrag(const u16* p) { return *(const bf16x8*)p; }
__device__ __forceinline__ float wave_sum(float v) {
#pragma unroll
    for (int o = 1; o < 64; o <<= 1) v += __shfl_xor(v, o);
    return v;
}
__device__ __forceinline__ float rcpf_(float x) { return __builtin_amdgcn_rcpf(x); }
__device__ __forceinline__ float sigmoidf_(float x) { return rcpf_(1.f + __expf(-x)); }
__device__ __forceinline__ float softplusf_(float x) { return fmaxf(x, 0.f) + __logf(1.f + __expf(-fabsf(x))); }
__device__ __forceinline__ float logsigmoidf_(float x) { return -softplusf_(-x); }
__device__ __forceinline__ float gelu_tanh(float x) { const float u = 0.7978845608028654f * (x + 0.044715f * x * x * x); return x * sigmoidf_(2.f * u); }

constexpr int LP = 72;
constexpr int FP = 65;

template <int MODE>
__device__ __forceinline__ void conv_weight(const float* __restrict__ W, int K, int N, int Npad, u16* __restrict__ WT, float* scr, int it, int lane) {
    const int nblk = Npad / 64;
    const int kr = lane >> 4, nc = lane & 15;
    {
        const int nb = it % nblk, kb = it / nblk;
        int col;
        if (MODE == 0) { col = nb * 64 + 4 * nc; if (col >= N) col = -1; }
        else if (MODE == 1) col = (nc < 8) ? nb * 32 + 4 * nc : DFF + nb * 32 + 4 * (nc - 8);
        else { const int r = nb * 64 + 4 * nc; col = (r < 1024) ? r : (r < 3072 ? r + 32 : (r < 3104 ? r - 2048 : -1)); }
        f32x4 v[16];
#pragma unroll
        for (int i = 0; i < 16; ++i) v[i] = (col >= 0) ? *(const f32x4*)(W + (size_t)(kb * 64 + 4 * i + kr) * N + col) : (f32x4){0.f, 0.f, 0.f, 0.f};
#pragma unroll
        for (int i = 0; i < 16; ++i) { float* s = scr + (4 * i + kr) * 65 + 4 * nc; s[0] = v[i].x; s[1] = v[i].y; s[2] = v[i].z; s[3] = v[i].w; }
        asm volatile("s_waitcnt lgkmcnt(0)" ::: "memory");
        int sc = lane;
        if (MODE == 1) { const int blk = lane >> 3, w = lane & 7; sc = (w < 4) ? blk * 4 + w : 32 + blk * 4 + (w - 4); }
        u16* dst = WT + (size_t)(nb * 64 + lane) * K + kb * 64;
#pragma unroll
        for (int kc = 0; kc < 8; ++kc) { float f[8];
#pragma unroll
            for (int j2 = 0; j2 < 8; ++j2) f[j2] = scr[(kc * 8 + j2) * 65 + sc];
            u32x4 o; PACK8(o, f); *(u32x4*)(dst + kc * 8) = o; }
        asm volatile("s_waitcnt lgkmcnt(0)" ::: "memory");
    }
}

__device__ __forceinline__ void row_pass(int mode, const float* xin, float* xout, const u16* yo, const float* g_post, const float* g_next, u16* hout, int gw, int ngw, int lane) {
    for (int row = gw; row < MTOK; row += ngw) {
        f32x4 xv[4];
#pragma unroll
        for (int j = 0; j < 4; ++j) xv[j] = *(const f32x4*)(xin + (size_t)row * DM + 4 * lane + 256 * j);
        if (mode == 1) {
            f32x4 yv[4]; float ss = 0.f;
#pragma unroll
            for (int j = 0; j < 4; ++j) { const uint2 w = *(const uint2*)(yo + (size_t)row * DM + 4 * lane + 256 * j);
                yv[j] = (f32x4){blo(w.x), bhi(w.x), blo(w.y), bhi(w.y)}; ss += yv[j].x * yv[j].x + yv[j].y * yv[j].y + yv[j].z * yv[j].z + yv[j].w * yv[j].w; }
            const float rs = rsqrtf(wave_sum(ss) * (1.f / DM) + EPS);
#pragma unroll
            for (int j = 0; j < 4; ++j) { const f32x4 g = *(const f32x4*)(g_post + 4 * lane + 256 * j); xv[j] = xv[j] + yv[j] * rs * g;
                *(f32x4*)(xout + (size_t)row * DM + 4 * lane + 256 * j) = xv[j]; }
        }
        if (g_next) {
            float ss = 0.f;
#pragma unroll
            for (int j = 0; j < 4; ++j) ss += xv[j].x * xv[j].x + xv[j].y * xv[j].y + xv[j].z * xv[j].z + xv[j].w * xv[j].w;
            const float rs = rsqrtf(wave_sum(ss) * (1.f / DM) + EPS);
#pragma unroll
            for (int j = 0; j < 4; ++j) { const f32x4 g = *(const f32x4*)(g_next + 4 * lane + 256 * j); const f32x4 v = xv[j] * rs * g;
                uint2 w; w.x = pk2(v.x, v.y); w.y = pk2(v.z, v.w);
                *(uint2*)(hout + (size_t)row * DM + 4 * lane + 256 * j) = w; }
        }
    }
}

__device__ __forceinline__ void prologue(int tid, int lane, int wave, int bid, int G, unsigned char* lds) {
    PP pp = get_pp();
    float* scr = (float*)(lds + wave * (64 * 65 * 4));
    unsigned char* ws = pp->ws;
    const int gw = bid * 8 + wave, ngw = G * 8;
    const int gt = bid * NTHR + tid, ngt = G * NTHR;
    constexpr int I_IN = (DIN_PAD / 64) * (DM / 64), I_OUT = (DM / 64) * (DM / 64), I_F1 = (2 * DFF / 64) * (DM / 64), I_F2 = (DM / 64) * (DFF / 64), I_L = I_IN + I_OUT + I_F1 + I_F2;
    for (int g = gw; g < DEPTH * I_L; g += ngw) {
        const int l = g / I_L; int r = g % I_L;
        if (r < I_IN) { conv_weight<ZSPLIT ? 2 : 0>(pp->in[3] + (size_t)l * DM * DIN, DM, DIN, DIN_PAD, (u16*)(ws + WS_WIN) + (size_t)l * DIN_PAD * DM, scr, r, lane); continue; } r -= I_IN;
        if (r < I_OUT) { conv_weight<0>(pp->in[15] + (size_t)l * DM * DM, DM, DM, DM, (u16*)(ws + WS_WOUT) + (size_t)l * DM * DM, scr, r, lane); continue; } r -= I_OUT;
        if (r < I_F1) { conv_weight<1>(pp->in[18] + (size_t)l * DM * 2 * DFF, DM, 2 * DFF, 2 * DFF, (u16*)(ws + WS_WF1) + (size_t)l * 2 * DFF * DM, scr, r, lane); continue; } r -= I_F1;
        conv_weight<0>(pp->in[19] + (size_t)l * DFF * DM, DFF, DM, DM, (u16*)(ws + WS_WF2) + (size_t)l * DM * DFF, scr, r, lane);
    }
    { u16* wt = (u16*)(ws + WS_LRUW);
      for (int idx = gt; idx < DEPTH * 2 * 2 * 4 * 4096; idx += ngt) {
          const int i = idx & 63, j = (idx >> 6) & 63, h = (idx >> 12) & 3, e = (idx >> 14) & 1, mat = (idx >> 15) & 1, l = idx >> 16;
          const float* W = mat ? pp->in[12] : pp->in[10];
          wt[idx] = (u16)f2bf(W[((((size_t)l * 2 + e) * 4 + h) * 64 + i) * 64 + j]); } }
    { float2* tab = (float2*)(ws + WS_ROPE);
      for (int idx = gt; idx < L_SEQ * 32; idx += ngt) { const int pos = idx >> 5, i = idx & 31;
          const float inv = powf(10000.f, -(float)(2 * i) / 64.f); const float ang = (float)pos * inv; float s, c; sincosf(ang, &s, &c); tab[idx] = make_float2(c, s); } }
    row_pass(0, pp->in[0], nullptr, nullptr, nullptr, pp->in[1], (u16*)(ws + WS_H), gw, ngw, lane);
}

constexpr int ATT_HALF_BYTES = 4 * 64 * LP * 2 + 2048;
__device__ __forceinline__ void rope8(u32x4& lo, u32x4& hi, const float2* tab) {
    float a[8], b[8], oa[8], ob[8]; UNPACK8(lo, a); UNPACK8(hi, b);
#pragma unroll
    for (int i = 0; i < 8; ++i) { const float2 cs = tab[i]; oa[i] = a[i] * cs.x - b[i] * cs.y; ob[i] = b[i] * cs.x + a[i] * cs.y; }
    PACK8(lo, oa); PACK8(hi, ob);
}
#define VT_SCATTER(dst, v) do { (dst)[0 * LP] = (u16)((v).x & 0xffff); (dst)[1 * LP] = (u16)((v).x >> 16); (dst)[2 * LP] = (u16)((v).y & 0xffff); (dst)[3 * LP] = (u16)((v).y >> 16); \
    (dst)[4 * LP] = (u16)((v).z & 0xffff); (dst)[5 * LP] = (u16)((v).z >> 16); (dst)[6 * LP] = (u16)((v).w & 0xffff); (dst)[7 * LP] = (u16)((v).w >> 16); } while (0)
template <int TYPE>
__device__ __forceinline__ void attn_unit(int layer, int uidx, unsigned char* hl, int ht) {
    PP pp = get_pp();
    const int lane = ht & 63, hw = ht >> 6, fr = lane & 15, fq = lane >> 4;
    u16* Qs = (u16*)hl; u16* Ks = Qs + 64 * LP; u16* Vt = Ks + 64 * LP; u16* Ps = Vt + 64 * LP; float* Bs = (float*)(Ps + 64 * LP);
    const u16* pbuf = (const u16*)(pp->ws + WS_P);
    const float2* rtab = (const float2*)(pp->ws + WS_ROPE);
    int b, h, r = 0, rs = 0, dil = 1, nb = 128, rho = 0, jb = 0, br = 0;
    if (TYPE == 0) { b = uidx >> 9; h = (uidx >> 7) & 3; r = uidx & 127; rs = min(max(r - 4, 0), 120); }
    else { br = uidx >> 10; const int rem = uidx & 1023; b = rem >> 9; h = (rem >> 7) & 3; const int w = rem & 127; dil = (br == 0) ? 1 : (br == 1 ? 4 : 16); nb = 128 / dil; rho = w / nb; jb = w % nb; }
    const int qtok0 = (TYPE == 0) ? r * 64 : rho + dil * 64 * jb; const int qstr = (TYPE == 0) ? 1 : dil;
    const size_t rowbase = (size_t)b * L_SEQ;
    const int qcol = ((TYPE == 0) ? C_QB : C_QD) + h * 64;
    const int nkb = (TYPE == 0) ? 8 : 3;
    const int srow = ht >> 2, sc = ht & 3;
#define KB_INFO(kb_, ktok0_, valid_) do { if (TYPE == 0) { ktok0_ = (rs + (kb_)) * 64; valid_ = true; } \
        else { const int d_ = ((kb_) == 0) ? 0 : ((kb_) == 1 ? -1 : 1); const int kj_ = jb + d_; valid_ = (kj_ >= 0 && kj_ < nb); ktok0_ = rho + dil * 64 * kj_; } } while (0)
    u32x4 klo, khi, vlo, vhi; int ptok = 0; bool pvalid;
    { int kt0; KB_INFO(0, kt0, pvalid); ptok = kt0 + qstr * srow;
      const u16* src = pbuf + (rowbase + ptok) * DIN + qcol + 256;
      klo = *(const u32x4*)(src + 8 * sc); khi = *(const u32x4*)(src + 32 + 8 * sc); vlo = *(const u32x4*)(src + 256 + 8 * sc); vhi = *(const u32x4*)(src + 256 + 32 + 8 * sc); }
    __syncthreads();
    { const int tok = qtok0 + qstr * srow; const u16* src = pbuf + (rowbase + tok) * DIN + qcol;
      u32x4 lo = *(const u32x4*)(src + 8 * sc), hi = *(const u32x4*)(src + 32 + 8 * sc);
      if (TYPE == 1) rope8(lo, hi, rtab + (size_t)tok * 32 + 8 * sc);
      *(u32x4*)(Qs + srow * LP + 8 * sc) = lo; *(u32x4*)(Qs + srow * LP + 32 + 8 * sc) = hi; }
    if (TYPE == 0) { const float* rpb = pp->in[7] + (size_t)(layer * 4 + h) * 465; for (int i = ht; i < 465; i += 256) Bs[i] = rpb[i]; }
    f32x4 o[4]; float mrow[4], lrow[4];
#pragma unroll
    for (int i = 0; i < 4; ++i) { o[i] = (f32x4){0.f, 0.f, 0.f, 0.f}; mrow[i] = -INFINITY; lrow[i] = 0.f; }
    bf16x8 aq0, aq1;
#pragma unroll 1
    for (int kb = 0; kb < nkb; ++kb) {
        const bool bvalid = pvalid;
        int delta = 0, dr = 0;
        if (TYPE == 0) dr = rs + kb - r; else delta = (kb == 0) ? 0 : (kb == 1 ? -1 : 1);
        int ntlo = 0, nthi = 3;
        if (TYPE == 0) { const int klo_ = min(max(16 * hw - 8, 0), 48), khi_ = min(max(16 * hw + 15 - 8, 0), 48) + 15; ntlo = klo_ >> 4; nthi = khi_ >> 4; }
        else { if (delta < 0) ntlo = hw; else if (delta > 0) nthi = hw; }
        if (kb > 0) __syncthreads();
        if (bvalid) {
            if (TYPE == 1) rope8(klo, khi, rtab + (size_t)ptok * 32 + 8 * sc);
            *(u32x4*)(Ks + srow * LP + 8 * sc) = klo; *(u32x4*)(Ks + srow * LP + 32 + 8 * sc) = khi;
            u16* v0 = Vt + (8 * sc) * LP + srow; u16* v1 = Vt + (32 + 8 * sc) * LP + srow;
            VT_SCATTER(v0, vlo); VT_SCATTER(v1, vhi); }
        if (kb + 1 < nkb) { int kt0; KB_INFO(kb + 1, kt0, pvalid); ptok = kt0 + qstr * srow;
            if (pvalid) { const u16* src = pbuf + (rowbase + ptok) * DIN + qcol + 256;
                klo = *(const u32x4*)(src + 8 * sc); khi = *(const u32x4*)(src + 32 + 8 * sc); vlo = *(const u32x4*)(src + 256 + 8 * sc); vhi = *(const u32x4*)(src + 256 + 32 + 8 * sc); } }
        __syncthreads();
        if (kb == 0) { aq0 = ldfrag(Qs + (16 * hw + fr) * LP + fq * 8); aq1 = ldfrag(Qs + (16 * hw + fr) * LP + 32 + fq * 8); }
        if (bvalid) {
            f32x4 s[4];
#pragma unroll
            for (int n = 0; n < 4; ++n) { s[n] = (f32x4){0.f, 0.f, 0.f, 0.f};
                if (n >= ntlo && n <= nthi) {
                    s[n] = mfma16(aq0, ldfrag(Ks + (16 * n + fr) * LP + fq * 8), s[n]);
                    s[n] = mfma16(aq1, ldfrag(Ks + (16 * n + fr) * LP + 32 + fq * 8), s[n]); } }
#pragma unroll
            for (int j = 0; j < 4; ++j) {
                const int qi = 16 * hw + 4 * fq + j;
                float mx = -INFINITY;
#pragma unroll
                for (int n = 0; n < 4; ++n) { const int kj = 16 * n + fr; bool ok; float v = s[n][j] * 0.125f;
                    if (TYPE == 0) { const int cs = min(max(qi - 8, 0), 48); ok = (kj >= cs) && (kj < cs + 16); const int dc = min(max(kj - qi, -15), 15); v += Bs[(dr + 7) * 31 + dc + 15]; }
                    else { ok = (delta == 0) ? true : (delta < 0 ? (kj >= qi) : (kj <= qi)); }
                    v = ok ? v : -INFINITY; s[n][j] = v; mx = fmaxf(mx, v); }
                mx = fmaxf(mx, __shfl_xor(mx, 1)); mx = fmaxf(mx, __shfl_xor(mx, 2)); mx = fmaxf(mx, __shfl_xor(mx, 4)); mx = fmaxf(mx, __shfl_xor(mx, 8));
                const float mnew = fmaxf(mrow[j], mx);
                const float msafe = (mnew == -INFINITY) ? 0.f : mnew;
                const float alpha = __expf(mrow[j] - msafe);
                float sum = 0.f;
#pragma unroll
                for (int n = 0; n < 4; ++n) { const float p = __expf(s[n][j] - msafe); sum += p; Ps[(16 * hw + 4 * fq + j) * LP + 16 * n + fr] = (u16)f2bf(p); }
                sum += __shfl_xor(sum, 1); sum += __shfl_xor(sum, 2); sum += __shfl_xor(sum, 4); sum += __shfl_xor(sum, 8);
                lrow[j] = lrow[j] * alpha + sum; mrow[j] = mnew;
#pragma unroll
                for (int nd = 0; nd < 4; ++nd) o[nd][j] *= alpha;
            }
        }
        __syncthreads();
        if (bvalid) {
#pragma unroll
            for (int kk = 0; kk < 2; ++kk) if (2 * kk + 1 >= ntlo && 2 * kk <= nthi) { const bf16x8 ap = ldfrag(Ps + (16 * hw + fr) * LP + 32 * kk + fq * 8);
#pragma unroll
                for (int nd = 0; nd < 4; ++nd) o[nd] = mfma16(ap, ldfrag(Vt + (16 * nd + fr) * LP + 32 * kk + fq * 8), o[nd]); }
        }
    }
#undef KB_INFO
#pragma unroll
    for (int j = 0; j < 4; ++j) {
        const int q = 16 * hw + 4 * fq + j; const int tok = qtok0 + qstr * q; const float inv = rcpf_(lrow[j]);
        if (TYPE == 0) { u16* y = (u16*)(pp->ws + WS_H) + (rowbase + tok) * DM + 256 + h * 64;
#pragma unroll
            for (int nd = 0; nd < 4; ++nd) y[16 * nd + fr] = (u16)f2bf(o[nd][j] * inv); }
        else { u16* d = (u16*)(pp->ws + WS_DAP) + ((size_t)br * MTOK + rowbase + tok) * 256 + h * 64;
#pragma unroll
            for (int nd = 0; nd < 4; ++nd) d[16 * nd + fr] = (u16)f2bf(o[nd][j] * inv);
            if (fr == 0) ((float*)(pp->ws + WS_DAL))[((size_t)br * MTOK + rowbase + tok) * 4 + h] = mrow[j] + __logf(lrow[j]); }
    }
}

constexpr int G1_ZS = 0;
constexpr int G1_WG = G1_ZS + 8192;
constexpr int G1_BG = G1_WG + 8192;
constexpr int G1_SEG = G1_BG + 512;
constexpr int G1_LA = G1_SEG + 4096;
constexpr int G1_T = G1_LA + 2 * 64 * FP * 4;
__device__ __forceinline__ void gla1_unit(int layer, int uidx, unsigned char* lds, int tid) {
    PP pp = get_pp();
    const int b = uidx >> 9, h = (uidx >> 7) & 3, n = uidx & 127;
    const int lane = tid & 63, w = tid >> 6, fr = lane & 15, fq = lane >> 4;
    float* ZS = (float*)(lds + G1_ZS); float* WG = (float*)(lds + G1_WG); float* BG = (float*)(lds + G1_BG); float* SEG = (float*)(lds + G1_SEG); float* LA = (float*)(lds + G1_LA);
    u16* KdT = (u16*)(lds + G1_T); u16* Vt = KdT + 2 * 64 * LP;
    const u16* pbuf = (const u16*)(pp->ws + WS_P);
    const size_t tok0 = (size_t)b * L_SEQ + n * 64;
    __syncthreads();
    { const int c = tid >> 3, part = tid & 7; const uint2 zz = *(const uint2*)(pbuf + (tok0 + c) * DIN + C_ZA + 4 * part);
      float* z = ZS + c * 32 + 4 * part; z[0] = blo(zz.x); z[1] = bhi(zz.x); z[2] = blo(zz.y); z[3] = bhi(zz.y);
#pragma unroll
      for (int q = 0; q < 4; ++q) { const int i = tid + 512 * q; const int e = i >> 10, rr = (i >> 6) & 15, ch = i & 63; WG[i] = pp->in[4][(((size_t)layer * 2 + e) * 16 + rr) * 256 + h * 64 + ch]; }
      if (tid < 128) { const int e = tid >> 6, ch = tid & 63; BG[tid] = pp->in[5][((size_t)layer * 2 + e) * 256 + h * 64 + ch]; } }
    __syncthreads();
    const int ch = tid & 63, seg = tid >> 6;
    float la0[8], la1[8];
#pragma unroll
    for (int i = 0; i < 8; ++i) { const int c = seg * 8 + i; float a0 = BG[ch], a1 = BG[64 + ch];
#pragma unroll
        for (int rr = 0; rr < 16; ++rr) { a0 += ZS[c * 32 + rr] * WG[rr * 64 + ch]; a1 += ZS[c * 32 + 16 + rr] * WG[1024 + rr * 64 + ch]; }
        la0[i] = logsigmoidf_(a0) * (1.f / 16.f); la1[i] = logsigmoidf_(a1) * (1.f / 16.f); }
#pragma unroll
    for (int i = 1; i < 8; ++i) la0[i] += la0[i - 1];
#pragma unroll
    for (int i = 6; i >= 0; --i) la1[i] += la1[i + 1];
    SEG[seg * 64 + ch] = la0[7]; SEG[512 + seg * 64 + ch] = la1[0];
    __syncthreads();
    { float pre0 = 0.f, pre1 = 0.f;
#pragma unroll
      for (int s2 = 0; s2 < 8; ++s2) { if (s2 < seg) pre0 += SEG[s2 * 64 + ch]; if (s2 > seg) pre1 += SEG[512 + s2 * 64 + ch]; }
      float* gb0 = (float*)(pp->ws + WS_GB) + (size_t)uidx * 4096; float* gb1 = gb0 + (size_t)1024 * 4096;
#pragma unroll
      for (int i = 0; i < 8; ++i) { const int c = seg * 8 + i; const float v0 = la0[i] + pre0, v1 = la1[i] + pre1;
          LA[c * FP + ch] = v0; LA[(64 + c) * FP + ch] = v1; gb0[c * 64 + ch] = v0; gb1[c * 64 + ch] = v1; } }
    __syncthreads();
    if (tid < 128) { const int e = tid >> 6, k = tid & 63; ((float*)(pp->ws + WS_GDEC))[((size_t)e * 1024 + uidx) * 64 + k] = __expf(LA[(e * 64 + (e ? 0 : 63)) * FP + k]); }
    { const int c = tid >> 3, kc = tid & 7; const u16* src = pbuf + (tok0 + c) * DIN + h * 64 + 8 * kc;
      const u32x4 kv = *(const u32x4*)(src + C_KA), vv = *(const u32x4*)(src + C_VA);
      float kf[8]; UNPACK8(kv, kf);
#pragma unroll
      for (int j = 0; j < 8; ++j) { const int k = 8 * kc + j;
          KdT[k * LP + c] = (u16)f2bf(kf[j] * __expf(LA[63 * FP + k] - LA[c * FP + k]));
          KdT[(64 + k) * LP + c] = (u16)f2bf(kf[j] * __expf(LA[64 * FP + k] - LA[(64 + c) * FP + k])); }
      u16* vt = Vt + (8 * kc) * LP + c; VT_SCATTER(vt, vv); }
    __syncthreads();
    { const int e = w >> 2, mt = w & 3;
      const bf16x8 a0 = ldfrag(KdT + (e * 64 + 16 * mt + fr) * LP + 8 * fq), a1 = ldfrag(KdT + (e * 64 + 16 * mt + fr) * LP + 32 + 8 * fq);
      float* kvout = (float*)(pp->ws + WS_GLA) + ((size_t)e * 1024 + uidx) * 4096;
#pragma unroll
      for (int nt = 0; nt < 4; ++nt) { f32x4 acc = (f32x4){0.f, 0.f, 0.f, 0.f};
          acc = mfma16(a0, ldfrag(Vt + (16 * nt + fr) * LP + 8 * fq), acc); acc = mfma16(a1, ldfrag(Vt + (16 * nt + fr) * LP + 32 + 8 * fq), acc);
#pragma unroll
          for (int j = 0; j < 4; ++j) kvout[(16 * mt + 4 * fq + j) * 64 + 16 * nt + fr] = acc[j]; } }
}

__device__ __forceinline__ void gla2_scan(int gt, int ngt) {
    PP pp = get_pp();
    float* KV = (float*)(pp->ws + WS_GLA); const float* DEC = (const float*)(pp->ws + WS_GDEC);
    for (int idx = gt; idx < 16 * 4096; idx += ngt) {
        const int seq = idx >> 12, kvi = idx & 4095, k = kvi >> 6; const int e = seq >> 3;
        float S = 0.f;
#pragma unroll 16
        for (int i = 0; i < 128; ++i) { const int n = e ? 127 - i : i; const size_t u = (size_t)seq * 128 + n;
            const float t = KV[u * 4096 + kvi]; const float d = DEC[u * 64 + k]; KV[u * 4096 + kvi] = S; S = S * d + t; }
    }
}

constexpr int G3_TB = 64 * LP * 2;
constexpr int G3_OS = 11 * G3_TB;
__device__ __forceinline__ void gla3_unit(int layer, int uidx, unsigned char* lds, int tid) {
    PP pp = get_pp();
    const int b = uidx >> 9, h = (uidx >> 7) & 3, n = uidx & 127;
    const int lane = tid & 63, w = tid >> 6, fr = lane & 15, fq = lane >> 4;
    u16* T = (u16*)lds;
    u16* Vt = T + 10 * 64 * LP; float* OS = (float*)(lds + G3_OS);
    const u16* pbuf = (const u16*)(pp->ws + WS_P);
    const size_t tok0 = (size_t)b * L_SEQ + n * 64;
    __syncthreads();
    { const int c = tid >> 3, kc = tid & 7; const u16* src = pbuf + (tok0 + c) * DIN + h * 64 + 8 * kc;
      const u32x4 qv = *(const u32x4*)(src + C_QA), kv = *(const u32x4*)(src + C_KA), vv = *(const u32x4*)(src + C_VA);
      float qf[8], kf[8]; UNPACK8(qv, qf); UNPACK8(kv, kf);
#pragma unroll
      for (int e = 0; e < 2; ++e) {
          const float* gb = (const float*)(pp->ws + WS_GB) + ((size_t)e * 1024 + uidx) * 4096;
          const f32x4 b0 = *(const f32x4*)(gb + c * 64 + 8 * kc), b1 = *(const f32x4*)(gb + c * 64 + 8 * kc + 4);
          const f32x4 m0 = *(const f32x4*)(gb + 32 * 64 + 8 * kc), m1 = *(const f32x4*)(gb + 32 * 64 + 8 * kc + 4);
          const float bv[8] = {b0.x, b0.y, b0.z, b0.w, b1.x, b1.y, b1.z, b1.w}; const float bm[8] = {m0.x, m0.y, m0.z, m0.w, m1.x, m1.y, m1.z, m1.w};
          float a[8], bb[8], cc[8];
#pragma unroll
          for (int j = 0; j < 8; ++j) { a[j] = qf[j] * 0.125f * __expf(bv[j] - bm[j]); bb[j] = kf[j] * __expf(bm[j] - bv[j]); cc[j] = qf[j] * 0.125f * __expf(bv[j]); }
          u32x4 o; PACK8(o, a); *(u32x4*)(T + ((0 + e) * 64 + c) * LP + 8 * kc) = o; PACK8(o, bb); *(u32x4*)(T + ((2 + e) * 64 + c) * LP + 8 * kc) = o; PACK8(o, cc); *(u32x4*)(T + ((4 + e) * 64 + c) * LP + 8 * kc) = o;
          const float* Sg = (const float*)(pp->ws + WS_GLA) + ((size_t)e * 1024 + uidx) * 4096;
          const f32x4 s0 = *(const f32x4*)(Sg + c * 64 + 8 * kc), s1 = *(const f32x4*)(Sg + c * 64 + 8 * kc + 4);
          u16* st = T + ((6 + e) * 64 + 8 * kc) * LP + c;
          st[0 * LP] = (u16)f2bf(s0.x); st[1 * LP] = (u16)f2bf(s0.y); st[2 * LP] = (u16)f2bf(s0.z); st[3 * LP] = (u16)f2bf(s0.w);
          st[4 * LP] = (u16)f2bf(s1.x); st[5 * LP] = (u16)f2bf(s1.y); st[6 * LP] = (u16)f2bf(s1.z); st[7 * LP] = (u16)f2bf(s1.w); }
      u16* vt = Vt + (8 * kc) * LP + c; VT_SCATTER(vt, vv); }
    __syncthreads();
    { const int e = w >> 2, mt = w & 3;
      const u16* Qe = T + (0 + e) * 64 * LP; const u16* Ke = T + (2 + e) * 64 * LP; u16* At = T + (8 + e) * 64 * LP;
      const bf16x8 a0 = ldfrag(Qe + (16 * mt + fr) * LP + 8 * fq), a1 = ldfrag(Qe + (16 * mt + fr) * LP + 32 + 8 * fq);
#pragma unroll
      for (int nt = 0; nt < 4; ++nt) { f32x4 acc = (f32x4){0.f, 0.f, 0.f, 0.f};
          acc = mfma16(a0, ldfrag(Ke + (16 * nt + fr) * LP + 8 * fq), acc); acc = mfma16(a1, ldfrag(Ke + (16 * nt + fr) * LP + 32 + 8 * fq), acc);
#pragma unroll
          for (int j = 0; j < 4; ++j) { const int c = 16 * mt + 4 * fq + j, s = 16 * nt + fr; const bool ok = (e == 0) ? (s <= c) : (s >= c);
              At[c * LP + s] = (u16)f2bf(ok ? acc[j] : 0.f); } } }
    __syncthreads();
    { const int mt = w >> 1;
      f32x4 oacc[2]; oacc[0] = (f32x4){0.f, 0.f, 0.f, 0.f}; oacc[1] = oacc[0];
#pragma unroll
      for (int e = 0; e < 2; ++e) { const u16* At = T + (8 + e) * 64 * LP; const u16* Qb = T + (4 + e) * 64 * LP; const u16* St = T + (6 + e) * 64 * LP;
#pragma unroll
          for (int kk = 0; kk < 2; ++kk) { const bf16x8 aA = ldfrag(At + (16 * mt + fr) * LP + 32 * kk + 8 * fq), aQ = ldfrag(Qb + (16 * mt + fr) * LP + 32 * kk + 8 * fq);
#pragma unroll
              for (int t = 0; t < 2; ++t) { const int nt = (w & 1) * 2 + t;
                  oacc[t] = mfma16(aA, ldfrag(Vt + (16 * nt + fr) * LP + 32 * kk + 8 * fq), oacc[t]);
                  oacc[t] = mfma16(aQ, ldfrag(St + (16 * nt + fr) * LP + 32 * kk + 8 * fq), oacc[t]); } } }
#pragma unroll
      for (int t = 0; t < 2; ++t) { const int nt = (w & 1) * 2 + t;
#pragma unroll
          for (int j = 0; j < 4; ++j) OS[(16 * mt + 4 * fq + j) * FP + 16 * nt + fr] = oacc[t][j]; } }
    __syncthreads();
    { const int c = tid >> 3, vc = tid & 7; float ov[8]; float ss = 0.f;
#pragma unroll
      for (int j = 0; j < 8; ++j) { ov[j] = OS[c * FP + 8 * vc + j]; ss += ov[j] * ov[j]; }
      ss += __shfl_xor(ss, 1); ss += __shfl_xor(ss, 2); ss += __shfl_xor(ss, 4);
      const float rs = rsqrtf(ss * (1.f / 64.f) + EPS);
      const u32x4 gv = *(const u32x4*)(pbuf + (tok0 + c) * DIN + C_GA + h * 64 + 8 * vc); float gf[8]; UNPACK8(gv, gf);
      const float* ng = pp->in[6] + (size_t)layer * 256 + h * 64 + 8 * vc;
#pragma unroll
      for (int j = 0; j < 8; ++j) ov[j] = ov[j] * rs * ng[j] * (gf[j] * sigmoidf_(gf[j]));
      u32x4 o; PACK8(o, ov);
      *(u32x4*)((u16*)(pp->ws + WS_H) + (tok0 + c) * DM + h * 64 + 8 * vc) = o; }
}

constexpr int LR_XF = 0;
constexpr int LR_XB = LR_XF + 64 * FP * 4;
constexpr int LR_A = LR_XB + 64 * LP * 2;
constexpr int LR_U = LR_A + 2 * 64 * FP * 4;
constexpr int LR_END = LR_U + 2 * 64 * FP * 4;
template <int PASS>
__device__ __forceinline__ void lru_unit(int layer, int uidx, unsigned char* lds, int tid) {
    PP pp = get_pp();
    const int b = uidx >> 9, n = (uidx >> 2) & 127, h = uidx & 3;
    const int lane = tid & 63, w = tid >> 6, fr = lane & 15, fq = lane >> 4;
    float* XF = (float*)(lds + LR_XF); u16* XB = (u16*)(lds + LR_XB); float* AS = (float*)(lds + LR_A); float* US = (float*)(lds + LR_U);
    const u16* pbuf = (const u16*)(pp->ws + WS_P);
    const size_t rowbase = (size_t)b * L_SEQ; const int t0 = n * 64;
    __syncthreads();
    { const int t = tid >> 3, cc = tid & 7; const int chg = h * 64 + 8 * cc;
      float acc[8];
#pragma unroll
      for (int j = 0; j < 8; ++j) acc[j] = pp->in[9][(size_t)layer * 256 + chg + j];
#pragma unroll
      for (int jj = 0; jj < 4; ++jj) { const int tt = t0 + t - 2 + jj;
          if (tt >= 0 && tt < L_SEQ) { const u32x4 xv = *(const u32x4*)(pbuf + (rowbase + tt) * DIN + C_XC + chg); float xf[8]; UNPACK8(xv, xf);
              const float* cw = pp->in[8] + ((size_t)layer * 4 + jj) * 256 + chg;
#pragma unroll
              for (int j = 0; j < 8; ++j) acc[j] += xf[j] * cw[j]; } }
#pragma unroll
      for (int j = 0; j < 8; ++j) XF[t * FP + 8 * cc + j] = acc[j];
      u32x4 o; PACK8(o, acc); *(u32x4*)(XB + t * LP + 8 * cc) = o; }
    __syncthreads();
    { const int mt = w & 3, e = w >> 2;
      const bf16x8 a0 = ldfrag(XB + (16 * mt + fr) * LP + 8 * fq), a1 = ldfrag(XB + (16 * mt + fr) * LP + 32 + 8 * fq);
      const u16* WA = (const u16*)(pp->ws + WS_LRUW) + ((((size_t)layer * 2 + 0) * 2 + e) * 4 + h) * 4096;
      const u16* WX = (const u16*)(pp->ws + WS_LRUW) + ((((size_t)layer * 2 + 1) * 2 + e) * 4 + h) * 4096;
#pragma unroll
      for (int nt = 0; nt < 4; ++nt) { const int jc = 16 * nt + fr;
          f32x4 ar = (f32x4){0.f, 0.f, 0.f, 0.f}, ai = ar;
          ar = mfma16(a0, ldfrag(WA + jc * 64 + 8 * fq), ar); ar = mfma16(a1, ldfrag(WA + jc * 64 + 32 + 8 * fq), ar);
          ai = mfma16(a0, ldfrag(WX + jc * 64 + 8 * fq), ai); ai = mfma16(a1, ldfrag(WX + jc * 64 + 32 + 8 * fq), ai);
          const int chg = h * 64 + jc;
          const float ba = pp->in[11][((size_t)layer * 2 + e) * 256 + chg], bx = pp->in[13][((size_t)layer * 2 + e) * 256 + chg];
          const float sp = softplusf_(-pp->in[14][((size_t)layer * 2 + e) * 256 + chg]);
#pragma unroll
          for (int j = 0; j < 4; ++j) { const int t = 16 * mt + 4 * fq + j;
              const float rg = sigmoidf_(ar[j] + ba), ig = sigmoidf_(ai[j] + bx);
              const float la = -8.f * rg * sp; const float a = __expf(la); const float u = __builtin_amdgcn_sqrtf(fmaxf(1.f - a * a, 0.f)) * (ig * XF[t * FP + jc]);
              AS[(e * 64 + t) * FP + jc] = a; US[(e * 64 + t) * FP + jc] = u; } } }
    __syncthreads();
    if (tid < 128) { const int e = tid >> 6, ch = tid & 63; const size_t cidx = ((size_t)(e * 2 + b) * 128 + n) * 256 + h * 64 + ch;
        if (PASS == 1) { float Pp = 1.f, H = 0.f;
            for (int i = 0; i < 64; ++i) { const int t = e ? 63 - i : i; const float a = AS[(e * 64 + t) * FP + ch], u = US[(e * 64 + t) * FP + ch]; Pp *= a; H = a * H + u; }
            ((float*)(pp->ws + WS_LRUA))[cidx] = Pp; ((float*)(pp->ws + WS_LRUH))[cidx] = H; }
        else { float H = ((const float*)(pp->ws + WS_LRUH))[cidx];
            for (int i = 0; i < 64; ++i) { const int t = e ? 63 - i : i; const float a = AS[(e * 64 + t) * FP + ch], u = US[(e * 64 + t) * FP + ch]; H = a * H + u; US[(e * 64 + t) * FP + ch] = H; } } }
    if (PASS == 3) {
        __syncthreads();
        const int t = tid >> 3, cc = tid & 7; const int chg = h * 64 + 8 * cc;
        const u32x4 gv = *(const u32x4*)(pbuf + (rowbase + t0 + t) * DIN + C_GC + chg); float gf[8], ov[8]; UNPACK8(gv, gf);
#pragma unroll
        for (int j = 0; j < 8; ++j) ov[j] = (US[t * FP + 8 * cc + j] + US[(64 + t) * FP + 8 * cc + j]) * gelu_tanh(gf[j]);
        u32x4 o; PACK8(o, ov);
        *(u32x4*)((u16*)(pp->ws + WS_H) + (rowbase + t0 + t) * DM + 512 + chg) = o;
    }
}
__device__ __forceinline__ void lru2_scan(int gt, int ngt) {
    PP pp = get_pp();
    const float* A = (const float*)(pp->ws + WS_LRUA); float* Hh = (float*)(pp->ws + WS_LRUH);
    for (int idx = gt; idx < 2 * 2 * 256; idx += ngt) { const int ch = idx & 255, eb = idx >> 8, e = eb >> 1;
        float H = 0.f;
#pragma unroll 4
        for (int i = 0; i < 128; ++i) { const int n = e ? 127 - i : i; const size_t c = ((size_t)eb * 128 + n) * 256 + ch; const float a = A[c], hl = Hh[c]; Hh[c] = H; H = a * H + hl; } }
}
__device__ __forceinline__ void da_combine(int gt, int ngt) {
    PP pp = get_pp();
    const u16* dap = (const u16*)(pp->ws + WS_DAP); const float* dal = (const float*)(pp->ws + WS_DAL); u16* y = (u16*)(pp->ws + WS_H);
    for (int idx = gt; idx < MTOK * 32; idx += ngt) { const int tok = idx >> 5, c = idx & 31, h = c >> 3;
        const float l0 = dal[(size_t)tok * 4 + h], l1 = dal[((size_t)MTOK + tok) * 4 + h], l2 = dal[((size_t)2 * MTOK + tok) * 4 + h];
        const float mx = fmaxf(l0, fmaxf(l1, l2)); float w0 = __expf(l0 - mx), w1 = __expf(l1 - mx), w2 = __expf(l2 - mx); const float inv = 1.f / (w0 + w1 + w2); w0 *= inv; w1 *= inv; w2 *= inv;
        const u32x4 v0 = *(const u32x4*)(dap + (size_t)tok * 256 + 8 * c), v1 = *(const u32x4*)(dap + ((size_t)MTOK + tok) * 256 + 8 * c), v2 = *(const u32x4*)(dap + ((size_t)2 * MTOK + tok) * 256 + 8 * c);
        float f0[8], f1[8], f2[8], ov[8]; UNPACK8(v0, f0); UNPACK8(v1, f1); UNPACK8(v2, f2);
#pragma unroll
        for (int j = 0; j < 8; ++j) ov[j] = w0 * f0[j] + w1 * f1[j] + w2 * f2[j];
        u32x4 o; PACK8(o, ov);
        *(u32x4*)(y + (size_t)tok * DM + 768 + 8 * c) = o; }
}

#define LAS __attribute__((address_space(3)))
#define XB_TMO      128
#define XB_XCNT(j)  (256  + 64 * (j))
#define XB_XSUB(j)  (1280 + 64 * (j))
#define XB_XGEN(j)  (2304 + 64 * (j))
#define XB_TOP      3328
#define XB_TOPGEN   3392
#define XCD_BAR_WORDS 3456
#define XB_SPIN_CAP (1u << 18)

__device__ __forceinline__ unsigned xb_ld(unsigned* p)              { return __hip_atomic_load(p, __ATOMIC_RELAXED, __HIP_MEMORY_SCOPE_AGENT); }
__device__ __forceinline__ unsigned xb_add(unsigned* p, unsigned v) { return __hip_atomic_fetch_add(p, v, __ATOMIC_RELAXED, __HIP_MEMORY_SCOPE_AGENT); }
__device__ __forceinline__ unsigned xb_xcc_id() { return (unsigned)__builtin_amdgcn_s_getreg((3 << 11) | 20) & 0xFu; }
#define XB_SPIN(cond, bar) do { unsigned _sp = 0; while (cond) { __builtin_amdgcn_s_sleep(1); \
    if ((++_sp & 255u) == 0u) { if (xb_ld(&(bar)[XB_TMO])) break; if (_sp > XB_SPIN_CAP) { atomicAdd(&(bar)[XB_TMO], 1u); break; } } } } while (0)

struct XcdBarrier {
    unsigned* bar; unsigned x;
    volatile LAS unsigned* st;
};

__device__ __forceinline__ XcdBarrier xcd_barrier_post(unsigned* bar, volatile LAS unsigned* st) {
    XcdBarrier b; b.bar = bar; b.x = xb_xcc_id(); b.st = st;
    if (threadIdx.x == 0) (void)xb_add(&bar[XB_XCNT(b.x)], 1u);
    return b;
}
__device__ __forceinline__ void xcd_barrier_complete(unsigned* bar, unsigned x, unsigned& nloc, unsigned& nx) {
    const unsigned G = gridDim.x * gridDim.y * gridDim.z;
    unsigned sum, cnt, mine, sp = 0u;
    for (;;) {
        sum = 0u; cnt = 0u; mine = 0u;
#pragma unroll
        for (unsigned j = 0; j < 16; ++j) { const unsigned c = xb_ld(&bar[XB_XCNT(j)]); sum += c; cnt += (c > 0u) ? 1u : 0u; mine = (j == x) ? c : mine; }
        if (sum == G) break;
        __builtin_amdgcn_s_sleep(1);
        if ((++sp & 255u) == 0u) { if (xb_ld(&bar[XB_TMO])) break; if (sp > XB_SPIN_CAP) { atomicAdd(&bar[XB_TMO], 1u); break; } }
    }
    nloc = mine > 0u ? mine : 1u; nx = cnt > 0u ? cnt : 1u;
}

__device__ __forceinline__ void xcd_barrier(const XcdBarrier& b) {
    asm volatile("s_waitcnt vmcnt(0)" ::: "memory");
    __syncthreads();
    if (threadIdx.x == 0) {
        unsigned* bar = b.bar;
        __builtin_amdgcn_s_waitcnt(0);
        unsigned nloc = b.st[0], nx = b.st[1];
        if (nloc == 0u) { xcd_barrier_complete(bar, b.x, nloc, nx); b.st[0] = nloc; b.st[1] = nx; }
        const unsigned old = xb_add(&bar[XB_XSUB(b.x)], 1u);
        const unsigned gen = old / nloc;
        if (old + 1u == (gen + 1u) * nloc) {
            __builtin_amdgcn_fence(__ATOMIC_RELEASE, "agent");
            asm volatile("s_waitcnt vmcnt(0)" ::: "memory");
            const unsigned og = xb_add(&bar[XB_TOP], 1u);
            const unsigned tg = og / nx;
            if (og + 1u == (tg + 1u) * nx) xb_add(&bar[XB_TOPGEN], 1u);
            else XB_SPIN(xb_ld(&bar[XB_TOPGEN]) == tg, bar);
            __builtin_amdgcn_fence(__ATOMIC_ACQUIRE, "agent");
            xb_add(&bar[XB_XGEN(b.x)], 1u);
            asm volatile("s_waitcnt vmcnt(0)" ::: "memory");
        } else {
            XB_SPIN(xb_ld(&bar[XB_XGEN(b.x)]) == gen, bar);
            __builtin_amdgcn_fence(__ATOMIC_ACQUIRE, "agent");
            asm volatile("s_waitcnt vmcnt(0)" ::: "memory");
        }
    }
    __syncthreads();
}


#define R_G 1
#define R_PRO 1
#define PROBE_MASK 0
#define XSYNC 0
#define R_NA 1
#define R_DA 1
#define R_GLA1 1
#define R_LRU1 1
#define R_GLA3 1
#define R_LRU3 1
#define R_DAC 1
__global__ void __launch_bounds__(NTHR, 2) hybrid_fwd(Params P) {
    extern __shared__ __attribute__((aligned(16))) unsigned char lds_raw[];
    cg::grid_group grid = cg::this_grid();
    const int ph_lo = P.ph_lo, ph_hi = P.ph_hi;
    int again = 0;
    { volatile LAS unsigned* st0 = (volatile LAS unsigned*)((LAS unsigned char*)lds_raw + (LDS_BYTES - 256));
      if (threadIdx.x < 2) st0[threadIdx.x] = 0u;
      __syncthreads();
      (void)xcd_barrier_post((unsigned*)(P.ws + WS_CTL), st0); }
#define GSYNC() do { XcdBarrier xb_; xb_.bar = (unsigned*)(get_pp()->ws + WS_CTL); xb_.x = xb_xcc_id(); xb_.st = (volatile LAS unsigned*)((LAS unsigned char*)lds_raw + (LDS_BYTES - 256)); xcd_barrier(xb_); } while (0)
    for (int ph = ph_lo; ph < ph_hi; ++ph) {
        PP pp = get_pp(); unsigned char* ws = pp->ws;
        int tid = threadIdx.x; asm volatile("" : "+v"(tid));
        int bid = blockIdx.x; asm volatile("" : "+s"(bid));
        int G = gridDim.x; asm volatile("" : "+s"(G));
        PG8_LAS unsigned char* l3 = (PG8_LAS unsigned char*)lds_raw; asm volatile("" : "+s"(l3));
        unsigned char* lds = (unsigned char*)l3;
        const int lane = tid & 63, wave = tid >> 6;
        const int gw = bid * 8 + wave, ngw = G * 8;
        const int gt = bid * NTHR + tid, ngt = G * NTHR;
        if (ph == 0) { for (int rep = 0; rep < R_PRO; ++rep) prologue(tid, lane, wave, bid, G, lds); }
        else {
            const int l = (ph - 1) / 9, t = (ph - 1) % 9;
#ifndef SKIP_G1
            if (t == 0 || t == 4 || t == 7) {
                pg8::Gemm g; pg8::EpiStore E;
                if (t == 0) { g = pg8::Gemm{(const u16*)(ws + WS_H), (const u16*)(ws + WS_WIN) + (size_t)l * DIN_PAD * DM, MTOK, ZSPLIT ? 3072 : DIN_PAD, DM}; E = ZSPLIT ? pg8::EpiStore{(u16*)(ws + WS_P), DIN, 3072, 1024, 32} : pg8::EpiStore{(u16*)(ws + WS_P), DIN, DIN, 1 << 30, 0}; }
                else if (t == 4) { g = pg8::Gemm{(const u16*)(ws + WS_H), (const u16*)(ws + WS_WOUT) + (size_t)l * DM * DM, MTOK, DM, DM}; E = pg8::EpiStore{(u16*)(ws + WS_P), DM, DM, 1 << 30, 0}; }
                else { g = pg8::Gemm{(const u16*)(ws + WS_P), (const u16*)(ws + WS_WF2) + (size_t)l * DM * DFF, MTOK, DM, DFF}; E = pg8::EpiStore{(u16*)(ws + WS_GLA), DM, DM, 1 << 30, 0}; }
                pg8::StaticOrder S; S.init(g.M, g.N, G, bid);
                for (int rep = 0; rep < R_G; ++rep) pg8::gemm_phase<pg8::EpiStore, pg8::StaticOrder, true, true>(l3, g, S, E, tid);
                if (ZSPLIT && t == 0) {
                    const int w = tid >> 6, fr = lane & 15, fq = lane >> 4, mt = w & 3, kh = w >> 2;
                    float* red = (float*)lds;
                    for (int rb = bid; rb < MTOK / 64; rb += G) {
                        const u16* A = (const u16*)(ws + WS_H) + (size_t)(rb * 64 + 16 * mt + fr) * DM + kh * 512 + 8 * fq;
                        const u16* B0 = (const u16*)(ws + WS_WIN) + ((size_t)l * DIN_PAD + 3072 + fr) * DM + kh * 512 + 8 * fq; const u16* B1 = B0 + 16 * DM;
                        f32x4 z0 = (f32x4){0.f, 0.f, 0.f, 0.f}, z1 = z0;
#pragma unroll
                        for (int hb = 0; hb < 2; ++hb) {
                            bf16x8 av[8], b0v[8], b1v[8];
#pragma unroll
                            for (int s = 0; s < 8; ++s) { av[s] = ldfrag(A + 32 * (8 * hb + s)); b0v[s] = ldfrag(B0 + 32 * (8 * hb + s)); b1v[s] = ldfrag(B1 + 32 * (8 * hb + s)); }
#pragma unroll
                            for (int s = 0; s < 8; ++s) { z0 = mfma16(av[s], b0v[s], z0); z1 = mfma16(av[s], b1v[s], z1); }
                        }
                        __syncthreads();
                        if (kh == 1) {
#pragma unroll
                            for (int j = 0; j < 4; ++j) { red[(16 * mt + 4 * fq + j) * 33 + fr] = z0[j]; red[(16 * mt + 4 * fq + j) * 33 + 16 + fr] = z1[j]; } }
                        __syncthreads();
                        if (kh == 0) { u16* pz = (u16*)(ws + WS_P) + (size_t)(rb * 64 + 16 * mt + 4 * fq) * DIN + C_ZA;
#pragma unroll
                            for (int j = 0; j < 4; ++j) { pz[(size_t)j * DIN + fr] = (u16)f2bf(z0[j] + red[(16 * mt + 4 * fq + j) * 33 + fr]); pz[(size_t)j * DIN + 16 + fr] = (u16)f2bf(z1[j] + red[(16 * mt + 4 * fq + j) * 33 + 16 + fr]); } }
                    }
                }
            } else
#endif
#ifndef SKIP_G3
            if (t == 6) {
                pg8::Gemm g{(const u16*)(ws + WS_H), (const u16*)(ws + WS_WF1) + (size_t)l * 2 * DFF * DM, MTOK, 2 * DFF, DM};
                pg8::EpiSwiGLU E{(u16*)(ws + WS_P), DFF};
                pg8::StaticOrder S; S.init(g.M, g.N, G, bid);
                for (int rep = 0; rep < R_G; ++rep) pg8::gemm_phase<pg8::EpiSwiGLU, pg8::StaticOrder, true, true>(l3, g, S, E, tid);
            } else
#endif
#ifndef SKIP_M1
            if (t == 1) {
                const int half = tid >> 8, ht = tid & 255; unsigned char* hl = lds + half * ATT_HALF_BYTES;
                for (int rep = 0; rep < R_NA; ++rep) for (int pi = bid; pi < 512; pi += G) attn_unit<0>(l, 2 * pi + half, hl, ht);
                for (int rep = 0; rep < R_DA; ++rep) for (int pi = bid; pi < 1536; pi += G) attn_unit<1>(l, 2 * pi + half, hl, ht);
                for (int rep = 0; rep < R_GLA1; ++rep) for (int u = bid; u < 1024; u += G) gla1_unit(l, u, lds, tid);
                for (int rep = 0; rep < R_LRU1; ++rep) for (int u = bid; u < 1024; u += G) lru_unit<1>(l, u, lds, tid);
            } else
#endif
            if (t == 2) {
                gla2_scan(gt, ngt);
                lru2_scan(gt, ngt);
            } else
#ifndef SKIP_M3
            if (t == 3) {
                for (int rep = 0; rep < R_GLA3; ++rep) for (int u = bid; u < 1024; u += G) gla3_unit(l, u, lds, tid);
                for (int rep = 0; rep < R_LRU3; ++rep) for (int u = bid; u < 1024; u += G) lru_unit<3>(l, u, lds, tid);
                for (int rep = 0; rep < R_DAC; ++rep) da_combine(gt, ngt);
            } else
#endif
            if (t == 5) {
                row_pass(1, l == 0 ? pp->in[0] : pp->out, pp->out, (const u16*)(ws + WS_P), pp->in[2] + (size_t)l * DM, pp->in[16] + (size_t)l * DM, (u16*)(ws + WS_H), gw, ngw, lane);
            } else if (t == 8) {
                row_pass(1, pp->out, pp->out, (const u16*)(ws + WS_GLA), pp->in[17] + (size_t)l * DM, (l + 1 < DEPTH) ? pp->in[1] + (size_t)(l + 1) * DM : nullptr, (u16*)(ws + WS_H), gw, ngw, lane);
            }
        }
        if (PROBE_MASK && ph > 0 && ((PROBE_MASK >> ((ph - 1) % 9)) & 1) && !again) { again = 1; --ph; GSYNC(); continue; }
        again = 0;
        for (int xs = 0; xs < XSYNC; ++xs) GSYNC();
        if (ph + 1 < ph_hi) { if (ph == 0) grid.sync(); else GSYNC(); }
    }
}

#ifndef N_LAUNCH_MODE
#define N_LAUNCH_MODE 1
#endif
constexpr int N_PHASES = 1 + 9 * DEPTH;
extern "C" void kernel_launch(void* const* d_in, const int* in_sizes, int n_in, void* d_out, int out_size, void* d_ws, size_t ws_size, hipStream_t stream) {
    static int grid = 0;
    if (grid == 0) {
        if (n_in != 20 || ws_size < WS_END) { fprintf(stderr, "kernel_launch: need 20 inputs and %zu B workspace (got %d, %zu)\n", (size_t)WS_END, n_in, ws_size); grid = -1; return; }
        int dev = 0, cus = 0, per_cu = 0;
        hipGetDevice(&dev); hipDeviceGetAttribute(&cus, hipDeviceAttributeMultiprocessorCount, dev);
        if (hipFuncSetAttribute((const void*)hybrid_fwd, hipFuncAttributeMaxDynamicSharedMemorySize, LDS_BYTES) != hipSuccess) { fprintf(stderr, "hipFuncSetAttribute failed\n"); grid = -1; return; }
        if (hipOccupancyMaxActiveBlocksPerMultiprocessor(&per_cu, (const void*)hybrid_fwd, NTHR, LDS_BYTES) != hipSuccess || per_cu < 1) { fprintf(stderr, "occupancy query: %d\n", per_cu); per_cu = 1; }
        (void)hipGetLastError();
        grid = cus * 1;
        if (per_cu < 1) grid = -1;
    }
    if (grid < 0) return;
    if (hipMemsetAsync((char*)d_ws + WS_CTL, 0, CTL_BYTES, stream) != hipSuccess) { fprintf(stderr, "memset failed\n"); return; }
    Params p{};
    for (int i = 0; i < 20; ++i) p.in[i] = (const float*)d_in[i];
    p.out = (float*)d_out; p.ws = (unsigned char*)d_ws;
#if N_LAUNCH_MODE == 1
    p.ph_lo = 0; p.ph_hi = N_PHASES;
    { void* args[] = {&p}; hipError_t e = hipLaunchCooperativeKernel((const void*)hybrid_fwd, dim3(grid), dim3(NTHR), args, LDS_BYTES, stream);
      if (e != hipSuccess) fprintf(stderr, "cooperative launch failed: %s\n", hipGetErrorString(e)); }
#else
    for (int ph = 0; ph < N_PHASES; ++ph) { p.ph_lo = ph; p.ph_hi = ph + 1; void* args[] = {&p};
        hipError_t e = hipLaunchCooperativeKernel((const void*)hybrid_fwd, dim3(grid), dim3(NTHR), args, LDS_BYTES, stream);
        if (e != hipSuccess) { fprintf(stderr, "launch %d failed: %s\n", ph, hipGetErrorString(e)); break; } }
#endif
}
```

```cpp
#include <hip/hip_runtime.h>
#include <hip/hip_cooperative_groups.h>
#include <cstdio>
#include <cstdint>
namespace cg = cooperative_groups;
namespace pg8 {
#define PG8_LAS __attribute__((address_space(3)))
typedef unsigned short bf16_t;
typedef short bf16x8 __attribute__((ext_vector_type(8)));
typedef float f32x4 __attribute__((ext_vector_type(4)));
typedef unsigned u32x4 __attribute__((ext_vector_type(4)));
constexpr int BM = 256, BK = 64, HALF = 128, HTB = HALF * BK * 2  , STAGE_BYTES = 8 * HTB, NXCD = 8, WGM = 8;

__host__ __device__ __forceinline__ int lds_byte(int r, int c) { const int st = (r >> 4) * 2 + (c >> 5), rr = r & 15, cc = c & 31, ob = rr * 64 + cc * 2; return st * 1024 + (ob ^ (((ob >> 9) & 1) << 5)); }
__host__ __device__ __forceinline__ void stage_rc(int b, int& R, int& C) { const int st = b / 1024, sb = b % 1024, swz = sb ^ (((sb >> 9) & 1) << 5); R = (st >> 1) * 16 + swz / 64; C = (st & 1) * 32 + (swz % 64) / 2; }
__host__ __device__ __forceinline__ int perm32(int rho) { const int n = rho >> 4, i = rho & 15; return 8 * (i >> 2) + 4 * n + (i & 3); }

struct Unit { int pm, pn; };
struct Gemm { const bf16_t* A; const bf16_t* Bt; int M, N, K; };

struct StaticOrder {
    int nM, nN, nwg, G, c;
    __host__ __device__ void init(int M, int N, int G_, int c_) { nM = M / BM; nN = N / BM; nwg = nM * nN; G = G_; c = c_; }
    __host__ __device__ bool next(int i, Unit& u) const {
        const long L = (long)i * G + c; if (L >= nwg) return false;
        int wgid = (int)L; { const int q = nwg / NXCD, r = nwg % NXCD, xcd = wgid % NXCD, off = wgid / NXCD; wgid = (xcd < r ? xcd * (q + 1) : r * (q + 1) + (xcd - r) * q) + off; }
        const int nig = WGM * nN, gid = wgid / nig, fm = gid * WGM, gsz = (nM - fm) < WGM ? (nM - fm) : WGM;
        u.pm = fm + ((wgid % nig) % gsz); u.pn = (wgid % nig) / gsz; return true;
    }
    __device__ __forceinline__ void a_ready(const Unit&) const {}
    __device__ __forceinline__ void done(const Unit&) const {}
};

__device__ __forceinline__ unsigned cvt_pk_bf16(float lo, float hi) { unsigned r; asm volatile("v_cvt_pk_bf16_f32 %0, %1, %2" : "=v"(r) : "v"(lo), "v"(hi)); return r; }
template <class Epi, class Sched, bool ALIGN_EPI = false, bool SP2 = false>
__device__ __forceinline__ void gemm_phase(PG8_LAS unsigned char* lds, const Gemm g, const Sched& S, const Epi& E, const int tid) {
    const int wid = __builtin_amdgcn_readfirstlane(tid >> 6), lane = tid & 63, wr = wid >> 2, wc = wid & 3, fr = lane & 15, fq = lane >> 4;
    const int K = g.K, nt = K / BK;
    unsigned voffA[2], voffB[2];
#pragma unroll
    for (int i = 0; i < 2; ++i) { int R, C; stage_rc(tid * 16 + i * 8192, R, C); const int Rb = Epi::PERM ? ((R & ~31) + perm32(R & 31)) : R;
        voffA[i] = (unsigned)(R * K + C) * 2u; voffB[i] = (unsigned)(Rb * K + C) * 2u; }
    const size_t kstep = (size_t)(BK * 2);
    const size_t hstep = (size_t)HALF * K * 2;
    const size_t tstep = 2 * hstep;
    const unsigned ldsw = (unsigned)wid * 1024u;
    const int aoff = lds_byte(wr * 64 + fr, fq * 8), boff = lds_byte(wc * 32 + fr, fq * 8);
#define PG8_SA(b, h) (((b) * 2 + (h)) * HTB)
#define PG8_SB(b, h) ((4 + (b) * 2 + (h)) * HTB)
#define PG8_STAGE(bufoff, gbase, voff) do { _Pragma("unroll") for (int _i = 0; _i < 2; ++_i) \
        __builtin_amdgcn_global_load_lds((const unsigned*)((const char*)(gbase) + (voff)[_i]), (PG8_LAS unsigned*)(lds + (bufoff) + ldsw + _i * 8192), 16, 0, 0); } while (0)
#define PG8_LDA(dst, b, h) do { _Pragma("unroll") for (int m = 0; m < 4; ++m) _Pragma("unroll") for (int k = 0; k < 2; ++k) dst[m][k] = *(const PG8_LAS bf16x8*)(lds + PG8_SA(b, h) + aoff + m * 2048 + k * 1024); } while (0)
#define PG8_LDB(dst, b, h) do { _Pragma("unroll") for (int n = 0; n < 2; ++n) _Pragma("unroll") for (int k = 0; k < 2; ++k) dst[n][k] = *(const PG8_LAS bf16x8*)(lds + PG8_SB(b, h) + boff + n * 2048 + k * 1024); } while (0)
#define PG8_MMA(ai, bj, At, Bt) do { __builtin_amdgcn_s_setprio(1); _Pragma("unroll") for (int m = 0; m < 4; ++m) _Pragma("unroll") for (int n = 0; n < 2; ++n) _Pragma("unroll") for (int k = 0; k < 2; ++k) \
        acc[ai][bj][m][n] = __builtin_amdgcn_mfma_f32_16x16x32_bf16(Bt[n][k], At[m][k], acc[ai][bj][m][n], 0, 0, 0); __builtin_amdgcn_s_setprio(0); } while (0)
#define PG8_WAIT_V(n) asm volatile("s_waitcnt vmcnt(" #n ")" ::: "memory")
#define PG8_WAIT_L(n) asm volatile("s_waitcnt lgkmcnt(" #n ")" ::: "memory")
#define PG8_BAR __builtin_amdgcn_s_barrier()
#define PG8_SCHED __builtin_amdgcn_sched_barrier(0)
    Unit cur, nxt; int ui = 0;
    if (!S.next(0, cur)) return;
    f32x4 acc[2][2][4][2];
#pragma unroll
    for (int a = 0; a < 2; ++a)
#pragma unroll
        for (int b = 0; b < 2; ++b)
#pragma unroll
            for (int m = 0; m < 4; ++m)
#pragma unroll
                for (int n = 0; n < 2; ++n) acc[a][b][m][n] = (f32x4){0.f, 0.f, 0.f, 0.f};
    bf16x8 At[4][2], B0[2][2], B1[2][2];
    const char* cA = (const char*)g.A + (size_t)cur.pm * tstep; const char* cB = (const char*)g.Bt + (size_t)cur.pn * tstep;
    S.a_ready(cur);
    if constexpr (SP2) {
        PG8_STAGE(PG8_SB(0, 0), cB, voffB); PG8_STAGE(PG8_SB(0, 1), cB + hstep, voffB); PG8_STAGE(PG8_SA(0, 0), cA, voffA); PG8_STAGE(PG8_SA(0, 1), cA + hstep, voffA);
        if (wr == 1) PG8_BAR;
        PG8_WAIT_V(2); PG8_BAR;
        PG8_STAGE(PG8_SB(1, 0), cB + kstep, voffB); PG8_STAGE(PG8_SA(1, 0), cA + kstep, voffA); PG8_STAGE(PG8_SB(1, 1), cB + hstep + kstep, voffB);
        PG8_WAIT_V(6); PG8_BAR;
    } else {
        PG8_STAGE(PG8_SB(0, 0), cB, voffB); PG8_STAGE(PG8_SA(0, 0), cA, voffA); PG8_STAGE(PG8_SB(0, 1), cB + hstep, voffB); PG8_STAGE(PG8_SA(0, 1), cA + hstep, voffA);
        if (wr == 1) PG8_BAR;
        PG8_WAIT_V(4); PG8_BAR;
        PG8_STAGE(PG8_SB(1, 0), cB + kstep, voffB); PG8_STAGE(PG8_SA(1, 0), cA + kstep, voffA); PG8_STAGE(PG8_SB(1, 1), cB + hstep + kstep, voffB);
        PG8_WAIT_V(6); PG8_BAR;
    }
    for (;;) {
        const bool has_next = S.next(ui + 1, nxt);
        const char* nA = has_next ? (const char*)g.A + (size_t)nxt.pm * tstep : cA; const char* nB = has_next ? (const char*)g.Bt + (size_t)nxt.pn * tstep : cB;
        for (int t = 0; t < nt; t += 2) {
            const bool last = (t == nt - 2);
            const char* a1 = cA + (size_t)(t + 1) * kstep;
            const char* a2 = last ? nA : cA + (size_t)(t + 2) * kstep; const char* b2 = last ? nB : cB + (size_t)(t + 2) * kstep;
            const char* a3 = a2 + kstep; const char* b3 = b2 + kstep;
            if (last && has_next) S.a_ready(nxt);
            if constexpr (SP2) {
            PG8_LDB(B0, 0, 0); PG8_LDB(B1, 0, 1); PG8_SCHED; PG8_LDA(At, 0, 0); PG8_STAGE(PG8_SA(1, 1), a1 + hstep, voffA);
            PG8_WAIT_V(8); PG8_WAIT_L(0); PG8_BAR; PG8_MMA(0, 0, At, B0); PG8_MMA(0, 1, At, B1); PG8_BAR; PG8_SCHED;
            PG8_LDA(At, 0, 1); PG8_STAGE(PG8_SB(0, 0), b2, voffB); PG8_STAGE(PG8_SB(0, 1), b2 + hstep, voffB); PG8_STAGE(PG8_SA(0, 0), a2, voffA);
            PG8_WAIT_V(8); PG8_WAIT_L(0); PG8_BAR; PG8_MMA(1, 0, At, B0); PG8_MMA(1, 1, At, B1); PG8_BAR; PG8_SCHED;
            PG8_LDB(B0, 1, 0); PG8_LDB(B1, 1, 1); PG8_SCHED; PG8_LDA(At, 1, 0); PG8_STAGE(PG8_SA(0, 1), a2 + hstep, voffA);
            PG8_WAIT_V(8); PG8_WAIT_L(0); PG8_BAR; PG8_MMA(0, 0, At, B0); PG8_MMA(0, 1, At, B1); PG8_BAR; PG8_SCHED;
            PG8_LDA(At, 1, 1); PG8_STAGE(PG8_SB(1, 0), b3, voffB); PG8_STAGE(PG8_SB(1, 1), b3 + hstep, voffB); PG8_STAGE(PG8_SA(1, 0), a3, voffA);
            PG8_WAIT_V(8); PG8_WAIT_L(0); PG8_BAR; PG8_MMA(1, 0, At, B0); PG8_MMA(1, 1, At, B1); PG8_BAR; PG8_SCHED;
            } else {
            PG8_LDB(B0, 0, 0); PG8_SCHED; PG8_LDA(At, 0, 0); PG8_STAGE(PG8_SA(1, 1), a1 + hstep, voffA);
            PG8_WAIT_L(8); PG8_BAR; PG8_WAIT_L(0); PG8_MMA(0, 0, At, B0); PG8_BAR; PG8_SCHED;
            PG8_LDB(B1, 0, 1); PG8_STAGE(PG8_SB(0, 0), b2, voffB);
            PG8_BAR; PG8_WAIT_L(0); PG8_MMA(0, 1, At, B1); PG8_BAR;
            PG8_LDA(At, 0, 1); PG8_STAGE(PG8_SA(0, 0), a2, voffA);
            PG8_BAR; PG8_WAIT_L(0); PG8_MMA(1, 0, At, B0); PG8_BAR; PG8_SCHED;
            PG8_STAGE(PG8_SB(0, 1), b2 + hstep, voffB);
            PG8_WAIT_V(6); PG8_BAR; PG8_MMA(1, 1, At, B1); PG8_BAR;
            PG8_LDB(B0, 1, 0); PG8_SCHED; PG8_LDA(At, 1, 0); PG8_STAGE(PG8_SA(0, 1), a2 + hstep, voffA);
            PG8_WAIT_L(8); PG8_BAR; PG8_WAIT_L(0); PG8_MMA(0, 0, At, B0); PG8_BAR; PG8_SCHED;
            PG8_LDB(B1, 1, 1); PG8_STAGE(PG8_SB(1, 0), b3, voffB);
            PG8_BAR; PG8_WAIT_L(0); PG8_MMA(0, 1, At, B1); PG8_BAR;
            PG8_LDA(At, 1, 1); PG8_STAGE(PG8_SA(1, 0), a3, voffA);
            PG8_BAR; PG8_WAIT_L(0); PG8_MMA(1, 0, At, B0); PG8_BAR; PG8_SCHED;
            PG8_STAGE(PG8_SB(1, 1), b3 + hstep, voffB);
            PG8_WAIT_V(6); PG8_BAR; PG8_MMA(1, 1, At, B1); PG8_BAR;
            }
        }
        if constexpr (ALIGN_EPI) { if (wr == 0) PG8_BAR; }
        if constexpr (!Epi::AFTER_DRAIN) { E(acc, cur, wr, wc, fr, fq); S.done(cur); }
        if (!has_next) break;
#pragma unroll
        for (int a = 0; a < 2; ++a)
#pragma unroll
            for (int b = 0; b < 2; ++b)
#pragma unroll
                for (int m = 0; m < 4; ++m)
#pragma unroll
                    for (int n = 0; n < 2; ++n) acc[a][b][m][n] = (f32x4){0.f, 0.f, 0.f, 0.f};
        cur = nxt; cA = nA; cB = nB; ++ui;
        if constexpr (ALIGN_EPI) { if (wr == 1) PG8_BAR; }
    }
    PG8_WAIT_V(0);
    if constexpr (!ALIGN_EPI) { if (wr == 0) PG8_BAR; }
    PG8_BAR;
    if constexpr (Epi::AFTER_DRAIN) { E.fused(acc, cur, wr, wc, fr, fq, lds, wid, lane); S.done(cur); }
#undef PG8_SA
#undef PG8_SB
#undef PG8_STAGE
#undef PG8_LDA
#undef PG8_LDB
#undef PG8_MMA
#undef PG8_WAIT_V
#undef PG8_WAIT_L
#undef PG8_BAR
#undef PG8_SCHED
}
}

namespace pg8 {
struct EpiStore {
    static constexpr bool PERM = true, AFTER_DRAIN = false;
    bf16_t* O; int ldc; int ncols; int shift_from, shift;
    __device__ __forceinline__ void operator()(const f32x4 (&acc)[2][2][4][2], const Unit& u, int wr, int wc, int fr, int fq) const {
        const int row0 = u.pm * BM + wr * 64 + fr; const int col0 = u.pn * BM + wc * 32 + 8 * fq;
#pragma unroll
        for (int ai = 0; ai < 2; ++ai)
#pragma unroll
            for (int m = 0; m < 4; ++m) { bf16_t* rowp = O + (size_t)(row0 + ai * HALF + m * 16) * ldc;
#pragma unroll
                for (int bj = 0; bj < 2; ++bj) { const int col = col0 + bj * HALF;
                    if (col < ncols) { const f32x4 v0 = acc[ai][bj][m][0], v1 = acc[ai][bj][m][1];
                        u32x4 w; w.x = cvt_pk_bf16(v0[0], v0[1]); w.y = cvt_pk_bf16(v0[2], v0[3]); w.z = cvt_pk_bf16(v1[0], v1[1]); w.w = cvt_pk_bf16(v1[2], v1[3]);
                        *(u32x4*)(rowp + col + (col >= shift_from ? shift : 0)) = w; } } }
    }
};
struct EpiSwiGLU {
    static constexpr bool PERM = true, AFTER_DRAIN = false;
    bf16_t* O; int ldc;
    __device__ __forceinline__ void operator()(const f32x4 (&acc)[2][2][4][2], const Unit& u, int wr, int wc, int fr, int fq) const {
        const int row0 = u.pm * BM + wr * 64 + fr; const int col0 = u.pn * BM + wc * 32 + 8 * fq;
#pragma unroll
        for (int ai = 0; ai < 2; ++ai)
#pragma unroll
            for (int m = 0; m < 4; ++m) { bf16_t* rowp = O + (size_t)(row0 + ai * HALF + m * 16) * ldc;
#pragma unroll
                for (int bj = 0; bj < 2; ++bj) { const int col = col0 + bj * HALF; const f32x4 g = acc[ai][bj][m][0], up = acc[ai][bj][m][1];
                    float r[4];
#pragma unroll
                    for (int i = 0; i < 4; ++i) r[i] = g[i] * __builtin_amdgcn_rcpf(1.f + __expf(-g[i])) * up[i];
                    uint2 w; w.x = cvt_pk_bf16(r[0], r[1]); w.y = cvt_pk_bf16(r[2], r[3]);
                    *(uint2*)(rowp + (col >> 1)) = w; } }
    }
};

struct PanelStats {
    unsigned* xbuf;
    unsigned* cnt;
    unsigned* tmo;
    int ntn; float eps;
    unsigned code;
    __device__ __forceinline__ bool run(const f32x4 (&v)[2][2][4][2], const Unit& u, int wr, int wc, int fr, int fq, PG8_LAS unsigned char* lds, int wid, int lane) const {
        typedef float f32x2v __attribute__((ext_vector_type(2)));
        PG8_LAS f32x2v* P = (PG8_LAS f32x2v*)lds;
        PG8_LAS f32x2v* S = (PG8_LAS f32x2v*)(lds + 8192);
        PG8_LAS unsigned* flag = (PG8_LAS unsigned*)(lds + 8192 + 2048);
#pragma unroll
        for (int ai = 0; ai < 2; ++ai)
#pragma unroll
            for (int m = 0; m < 4; ++m) {
                float s = 0.f;
#pragma unroll
                for (int bj = 0; bj < 2; ++bj)
#pragma unroll
                    for (int n = 0; n < 2; ++n) { const f32x4 x = v[ai][bj][m][n]; s += (x[0] + x[1]) + (x[2] + x[3]); }
                s += __shfl_xor(s, 16); s += __shfl_xor(s, 32);
                const float mw = s * (1.0f / 64.0f); float q = 0.f;
#pragma unroll
                for (int bj = 0; bj < 2; ++bj)
#pragma unroll
                    for (int n = 0; n < 2; ++n) { const f32x4 d = v[ai][bj][m][n] - mw; q += (d[0] * d[0] + d[1] * d[1]) + (d[2] * d[2] + d[3] * d[3]); }
                q += __shfl_xor(q, 16); q += __shfl_xor(q, 32);
                if (fq == 0) P[(ai * HALF + wr * 64 + m * 16 + fr) * 4 + wc] = (f32x2v){mw, q};
            }
        asm volatile("s_waitcnt lgkmcnt(0)" ::: "memory"); __builtin_amdgcn_s_barrier(); asm volatile("" ::: "memory");
        const int row = wid * 32 + (lane & 31);
        if (lane < 32) {
            const f32x2v a = P[row * 4 + 0], b = P[row * 4 + 1], c = P[row * 4 + 2], d = P[row * 4 + 3];
            const float mt = (a.x + b.x + c.x + d.x) * 0.25f;
            const float da = a.x - mt, db = b.x - mt, dc = c.x - mt, dd = d.x - mt;
            const float m2 = (a.y + b.y) + (c.y + d.y) + 64.0f * ((da * da + db * db) + (dc * dc + dd * dd));
            unsigned long long* slot = (unsigned long long*)xbuf + ((size_t)(u.pm * BM + row) * 4 + u.pn);
            __hip_atomic_store(slot, ((unsigned long long)__float_as_uint(m2) << 32) | __float_as_uint(mt), __ATOMIC_RELAXED, __HIP_MEMORY_SCOPE_AGENT);
        }
        asm volatile("s_waitcnt vmcnt(0)" ::: "memory");
        if (lane == 0) __hip_atomic_fetch_add(cnt + 64 * u.pm, 1u, __ATOMIC_RELAXED, __HIP_MEMORY_SCOPE_AGENT);
        if (wid == 0) {
            bool dead = false; const unsigned long long t0 = __builtin_amdgcn_s_memrealtime(); const unsigned want = 8u * (unsigned)ntn;
            for (;;) {
                if ((unsigned)__builtin_amdgcn_readfirstlane(__hip_atomic_load(cnt + 64 * u.pm, __ATOMIC_RELAXED, __HIP_MEMORY_SCOPE_AGENT)) >= want) break;
                if (__builtin_amdgcn_s_memrealtime() - t0 > 2000000ull) {
                    if (lane == 0) { unsigned expect = 0u; __hip_atomic_compare_exchange_strong(tmo + 1, &expect, code | (unsigned)(u.pm & 0xff), __ATOMIC_RELAXED, __ATOMIC_RELAXED, __HIP_MEMORY_SCOPE_AGENT);
                                     __hip_atomic_store(tmo, 1u, __ATOMIC_RELAXED, __HIP_MEMORY_SCOPE_AGENT); }
                    dead = true; break; }
                __builtin_amdgcn_s_sleep(2);
            }
            __builtin_amdgcn_fence(__ATOMIC_ACQUIRE, "agent");
            if (lane == 0) flag[0] = dead ? 1u : 0u;
        }
        asm volatile("s_waitcnt vmcnt(0) lgkmcnt(0)" ::: "memory"); __builtin_amdgcn_s_barrier(); asm volatile("" ::: "memory");
        const bool bad = flag[0] != 0u;
        if (lane < 32) {
            const unsigned long long* slot = (const unsigned long long*)xbuf + (size_t)(u.pm * BM + row) * 4; float mt[4], m2[4]; float ms = 0.f;
#pragma unroll
            for (int t = 0; t < 4; ++t) { if (t < ntn) { const unsigned long long w = __hip_atomic_load(slot + t, __ATOMIC_RELAXED, __HIP_MEMORY_SCOPE_AGENT); mt[t] = __uint_as_float((unsigned)w); m2[t] = __uint_as_float((unsigned)(w >> 32)); } else { mt[t] = 0.f; m2[t] = 0.f; } ms += mt[t]; }
            const float mean = ms / (float)ntn; float q = 0.f;
#pragma unroll
            for (int t = 0; t < 4; ++t) if (t < ntn) { const float dm = mt[t] - mean; q += m2[t] + 256.0f * dm * dm; }
            S[row] = (f32x2v){mean, 1.0f / sqrtf(q / (256.0f * (float)ntn) + mean * mean + eps)};
        }
        asm volatile("s_waitcnt lgkmcnt(0)" ::: "memory"); __builtin_amdgcn_s_barrier(); asm volatile("" ::: "memory");
        return bad;
    }
};

struct EpiRms2 {
    static constexpr bool PERM = true, AFTER_DRAIN = true;
    const float* base; float* out; bf16_t* xn; int ldc; const float* g1; const float* g2; PanelStats st1, st2;
    __device__ __forceinline__ void fused(f32x4 (&acc)[2][2][4][2], const Unit& u, int wr, int wc, int fr, int fq, PG8_LAS unsigned char* lds, int wid, int lane) const {
        typedef float f32x2v __attribute__((ext_vector_type(2)));
        const PG8_LAS f32x2v* S = (const PG8_LAS f32x2v*)(lds + 8192);
        const int col0 = u.pn * BM + wc * 32 + 8 * fq;
        bool bad = st1.run(acc, u, wr, wc, fr, fq, lds, wid, lane);
        const float qnan = __builtin_nanf("");
#pragma unroll
        for (int ai = 0; ai < 2; ++ai)
#pragma unroll
            for (int m = 0; m < 4; ++m) { const int r = ai * HALF + wr * 64 + m * 16 + fr; const f32x2v sr = S[r]; const size_t off = (size_t)(u.pm * BM + r) * ldc + col0;
#pragma unroll
                for (int bj = 0; bj < 2; ++bj)
#pragma unroll
                    for (int n = 0; n < 2; ++n) { const f32x4 bs = *(const f32x4*)(base + off + bj * HALF + n * 4); const f32x4 gv = *(const f32x4*)(g1 + col0 + bj * HALF + n * 4);
                        acc[ai][bj][m][n] = bs + acc[ai][bj][m][n] * sr.y * gv; }
                asm volatile("" : "+v"(acc[ai][0][m][0]), "+v"(acc[ai][0][m][1]), "+v"(acc[ai][1][m][0]), "+v"(acc[ai][1][m][1]));
                if (m & 1) asm volatile("" ::: "memory"); }
        const bool bad1 = bad;
        bad = st2.run(acc, u, wr, wc, fr, fq, lds, wid, lane) || bad;
#pragma unroll
        for (int ai = 0; ai < 2; ++ai)
#pragma unroll
            for (int m = 0; m < 4; ++m) { const int r = ai * HALF + wr * 64 + m * 16 + fr; const f32x2v sr = S[r]; const size_t off = (size_t)(u.pm * BM + r) * ldc + col0;
#pragma unroll
                for (int bj = 0; bj < 2; ++bj) { u32x4 w;
#pragma unroll
                    for (int n = 0; n < 2; ++n) { const f32x4 x1 = acc[ai][bj][m][n]; *(f32x4*)(out + off + bj * HALF + n * 4) = bad1 ? (f32x4){qnan, qnan, qnan, qnan} : x1;
                        const f32x4 gv = *(const f32x4*)(g2 + col0 + bj * HALF + n * 4);
                        const f32x4 o = x1 * sr.y * gv; if (n == 0) { w.x = cvt_pk_bf16(o[0], o[1]); w.y = cvt_pk_bf16(o[2], o[3]); } else { w.z = cvt_pk_bf16(o[0], o[1]); w.w = cvt_pk_bf16(o[2], o[3]); } }
                    if (bad) { w.x = 0x7fc07fc0u; w.y = 0x7fc07fc0u; w.z = 0x7fc07fc0u; w.w = 0x7fc07fc0u; }
                    *(u32x4*)(xn + off + bj * HALF) = w; }
                asm volatile("" ::: "memory"); }
    }
};
}

constexpr int L_SEQ = 8192, NB = 2, MTOK = NB * L_SEQ, DM = 1024, DIN = 3104, DIN_PAD = 3328, DFF = 2816, DEPTH = 4;
constexpr int C_QA = 0, C_KA = 256, C_VA = 512, C_GA = 768, C_ZA = 1024, C_QB = 1056, C_XC = 1824, C_GC = 2080, C_QD = 2336;
constexpr float EPS = 1e-6f;
#define FUSE_NORM 0
#define ZSPLIT 1
constexpr size_t A256(size_t x) { return (x + 255) & ~(size_t)255; }
constexpr size_t WS_CTL = 0, CTL_SEAM = 65536, CTL_TMO = 32768, CTL_BYTES = 65536 + 16 * 16384;
constexpr size_t WS_ROPE = CTL_BYTES;
constexpr size_t WS_LRUW = WS_ROPE + A256((size_t)L_SEQ * 32 * 8);
constexpr size_t WS_WIN  = WS_LRUW + A256((size_t)DEPTH * 2 * 2 * 4 * 4096 * 2);
constexpr size_t WS_WOUT = WS_WIN + (size_t)DEPTH * DIN_PAD * DM * 2;
constexpr size_t WS_WF1  = WS_WOUT + (size_t)DEPTH * DM * DM * 2;
constexpr size_t WS_WF2  = WS_WF1 + (size_t)DEPTH * 2 * DFF * DM * 2;
constexpr size_t WS_H    = WS_WF2 + (size_t)DEPTH * DM * DFF * 2;
constexpr size_t WS_P    = WS_H + (size_t)MTOK * DM * 2;
constexpr size_t WS_GLA  = WS_P + (size_t)MTOK * DIN * 2;
constexpr size_t WS_GDEC = WS_GLA + (size_t)2048 * 4096 * 4;
constexpr size_t WS_LRUA = WS_GDEC + (size_t)2048 * 64 * 4;
constexpr size_t WS_LRUH = WS_LRUA + (size_t)2 * 2 * 128 * 256 * 4;
constexpr size_t WS_DAP  = WS_LRUH + (size_t)2 * 2 * 128 * 256 * 4;
constexpr size_t WS_DAL  = WS_DAP + (size_t)3 * MTOK * 256 * 2;
constexpr size_t WS_GB   = WS_DAL + (size_t)3 * MTOK * 4 * 4;
constexpr size_t WS_XB   = WS_GB + (size_t)2048 * 4096 * 4;
constexpr size_t WS_END  = WS_XB + 2 * 524288;

constexpr int LDS_BYTES = 147456;
constexpr int NTHR = 512;

typedef unsigned short u16;
typedef short bf16x8 __attribute__((ext_vector_type(8)));
typedef float f32x4 __attribute__((ext_vector_type(4)));
typedef unsigned u32x4 __attribute__((ext_vector_type(4)));

struct Params { const float* in[20]; float* out; unsigned char* ws; int ph_lo, ph_hi; };
typedef const Params __attribute__((address_space(4)))* PP;
__device__ __forceinline__ PP get_pp() { PP p = (PP)__builtin_amdgcn_kernarg_segment_ptr(); asm volatile("" : "+s"(p)); return p; }

__device__ __forceinline__ unsigned f2bf(float f) { unsigned u = __float_as_uint(f); return (u + 0x7fffu + ((u >> 16) & 1u)) >> 16; }
__device__ __forceinline__ float bf2f(unsigned h) { return __uint_as_float(h << 16); }
__device__ __forceinline__ unsigned pk2(float lo, float hi) { return f2bf(lo) | (f2bf(hi) << 16); }
__device__ __forceinline__ float blo(unsigned w) { return __uint_as_float(w << 16); }
__device__ __forceinline__ float bhi(unsigned w) { return __uint_as_float(w & 0xffff0000u); }
#define UNPACK8(v, f) do { f[0] = blo(v.x); f[1] = bhi(v.x); f[2] = blo(v.y); f[3] = bhi(v.y); f[4] = blo(v.z); f[5] = bhi(v.z); f[6] = blo(v.w); f[7] = bhi(v.w); } while (0)
__device__ __forceinline__ unsigned cvtpk(float lo, float hi) { unsigned r; asm("v_cvt_pk_bf16_f32 %0, %1, %2" : "=v"(r) : "v"(lo), "v"(hi)); return r; }
#define PACK8(v, f) do { v.x = cvtpk(f[0], f[1]); v.y = cvtpk(f[2], f[3]); v.z = cvtpk(f[4], f[5]); v.w = cvtpk(f[6], f[7]); } while (0)
__device__ __forceinline__ f32x4 mfma16(bf16x8 a, bf16x8 b, f32x4 c) { return __builtin_amdgcn_mfma_f32_16x16x32_bf16(a, b, c, 0, 0, 0); }
__device__ __forceinline__ bf16x8 ldfrag(const u16* p) { return *(const bf16x8*)p; }
__device__ __forceinline__ float wave_sum(float v) {
#pragma unroll
    for (int o = 1; o < 64; o <<= 1) v += __shfl_xor(v, o);
    return v;
}
__device__ __forceinline__ float rcpf_(float x) { return __builtin_amdgcn_rcpf(x); }
__device__ __forceinline__ float sigmoidf_(float x) { return rcpf_(1.f + __expf(-x)); }
__device__ __forceinline__ float softplusf_(float x) { return fmaxf(x, 0.f) + __logf(1.f + __expf(-fabsf(x))); }
__device__ __forceinline__ float logsigmoidf_(float x) { return -softplusf_(-x); }
__device__ __forceinline__ float gelu_tanh(float x) { const float u = 0.7978845608028654f * (x + 0.044715f * x * x * x); return x * sigmoidf_(2.f * u); }

constexpr int LP = 72;
constexpr int FP = 65;

template <int MODE>
__device__ __forceinline__ void conv_weight(const float* __restrict__ W, int K, int N, int Npad, u16* __restrict__ WT, float* scr, int it, int lane) {
    const int nblk = Npad / 64;
    const int kr = lane >> 4, nc = lane & 15;
    {
        const int nb = it % nblk, kb = it / nblk;
        int col;
        if (MODE == 0) { col = nb * 64 + 4 * nc; if (col >= N) col = -1; }
        else if (MODE == 1) col = (nc < 8) ? nb * 32 + 4 * nc : DFF + nb * 32 + 4 * (nc - 8);
        else { const int r = nb * 64 + 4 * nc; col = (r < 1024) ? r : (r < 3072 ? r + 32 : (r < 3104 ? r - 2048 : -1)); }
        f32x4 v[16];
#pragma unroll
        for (int i = 0; i < 16; ++i) v[i] = (col >= 0) ? __builtin_nontemporal_load((const f32x4*)(W + (size_t)(kb * 64 + 4 * i + kr) * N + col)) : (f32x4){0.f, 0.f, 0.f, 0.f};
#pragma unroll
        for (int i = 0; i < 16; ++i) { float* s = scr + (4 * i + kr) * 65 + 4 * nc; s[0] = v[i].x; s[1] = v[i].y; s[2] = v[i].z; s[3] = v[i].w; }
        asm volatile("s_waitcnt lgkmcnt(0)" ::: "memory");
        int sc = lane;
        if (MODE == 1) { const int blk = lane >> 3, w = lane & 7; sc = (w < 4) ? blk * 4 + w : 32 + blk * 4 + (w - 4); }
        u16* dst = WT + (size_t)(nb * 64 + lane) * K + kb * 64;
#pragma unroll
        for (int kc = 0; kc < 8; ++kc) { float f[8];
#pragma unroll
            for (int j2 = 0; j2 < 8; ++j2) f[j2] = scr[(kc * 8 + j2) * 65 + sc];
            u32x4 o; PACK8(o, f); *(u32x4*)(dst + kc * 8) = o; }
        asm volatile("s_waitcnt lgkmcnt(0)" ::: "memory");
    }
}

__device__ __forceinline__ void row_pass(int mode, const float* xin, float* xout, const u16* yo, const float* g_post, const float* g_next, u16* hout, int gw, int ngw, int lane) {
    const int G_ = ngw >> 3, bid_ = gw >> 3, wv_ = gw & 7; const bool xa = (G_ % 8 == 0) && (MTOK % 8 == 0);
    const int rbase = xa ? (bid_ % 8) * (MTOK / 8) : 0, rcnt = xa ? MTOK / 8 : MTOK, lw = xa ? (bid_ / 8) * 8 + wv_ : gw, nlw = xa ? ngw / 8 : ngw;
    for (int r0 = lw; r0 < rcnt; r0 += 2 * nlw) {
        const int row0 = rbase + r0; const bool has1 = (r0 + nlw) < rcnt; const int rows[2] = {row0, row0 + nlw};
        f32x4 xv[2][4]; uint2 yw[2][4];
#pragma unroll
        for (int q = 0; q < 2; ++q) { const int row = (q == 0 || has1) ? rows[q] : row0;
#pragma unroll
            for (int j = 0; j < 4; ++j) { xv[q][j] = __builtin_nontemporal_load((const f32x4*)(xin + (size_t)row * DM + 4 * lane + 256 * j));
                if (mode == 1) { const unsigned long long t_ = __builtin_nontemporal_load((const unsigned long long*)(yo + (size_t)row * DM + 4 * lane + 256 * j)); yw[q][j] = make_uint2((unsigned)t_, (unsigned)(t_ >> 32)); } } }
        if (mode == 1) {
            float ss[2] = {0.f, 0.f}; f32x4 yv[2][4];
#pragma unroll
            for (int q = 0; q < 2; ++q)
#pragma unroll
                for (int j = 0; j < 4; ++j) { yv[q][j] = (f32x4){blo(yw[q][j].x), bhi(yw[q][j].x), blo(yw[q][j].y), bhi(yw[q][j].y)};
                    ss[q] += yv[q][j].x * yv[q][j].x + yv[q][j].y * yv[q][j].y + yv[q][j].z * yv[q][j].z + yv[q][j].w * yv[q][j].w; }
#pragma unroll
            for (int o = 1; o < 64; o <<= 1) { ss[0] += __shfl_xor(ss[0], o); ss[1] += __shfl_xor(ss[1], o); }
#pragma unroll
            for (int j = 0; j < 4; ++j) { const f32x4 g = *(const f32x4*)(g_post + 4 * lane + 256 * j);
#pragma unroll
                for (int q = 0; q < 2; ++q) { const float rs = rsqrtf(ss[q] * (1.f / DM) + EPS); xv[q][j] = xv[q][j] + yv[q][j] * rs * g;
                    if (q == 0 || has1) __builtin_nontemporal_store(xv[q][j], (f32x4*)(xout + (size_t)rows[q] * DM + 4 * lane + 256 * j)); } }
        }
        if (g_next) {
            float ss[2] = {0.f, 0.f};
#pragma unroll
            for (int q = 0; q < 2; ++q)
#pragma unroll
                for (int j = 0; j < 4; ++j) ss[q] += xv[q][j].x * xv[q][j].x + xv[q][j].y * xv[q][j].y + xv[q][j].z * xv[q][j].z + xv[q][j].w * xv[q][j].w;
#pragma unroll
            for (int o = 1; o < 64; o <<= 1) { ss[0] += __shfl_xor(ss[0], o); ss[1] += __shfl_xor(ss[1], o); }
#pragma unroll
            for (int j = 0; j < 4; ++j) { const f32x4 g = *(const f32x4*)(g_next + 4 * lane + 256 * j);
#pragma unroll
                for (int q = 0; q < 2; ++q) { const float rs = rsqrtf(ss[q] * (1.f / DM) + EPS); const f32x4 v = xv[q][j] * rs * g;
                    uint2 w; w.x = cvtpk(v.x, v.y); w.y = cvtpk(v.z, v.w);
                    if (q == 0 || has1) *(uint2*)(hout + (size_t)rows[q] * DM + 4 * lane + 256 * j) = w; } }
        }
    }
}

__device__ __forceinline__ void prologue(int tid, int lane, int wave, int bid, int G, unsigned char* lds) {
    PP pp = get_pp();
    float* scr = (float*)(lds + wave * (64 * 65 * 4));
    unsigned char* ws = pp->ws;
    const int gw = bid * 8 + wave, ngw = G * 8;
    const int gt = bid * NTHR + tid, ngt = G * NTHR;
    constexpr int I_IN = (DIN_PAD / 64) * (DM / 64), I_OUT = (DM / 64) * (DM / 64), I_F1 = (2 * DFF / 64) * (DM / 64), I_F2 = (DM / 64) * (DFF / 64);
    for (int l = 0; l < DEPTH; ++l) {
        const int o0 = (l * (I_IN + I_OUT + I_F1 + I_F2)) % ngw, o1 = (o0 + I_IN) % ngw, o2 = (o1 + I_OUT) % ngw, o3 = (o2 + I_F1) % ngw;
        for (int r = (gw + ngw - o0) % ngw; r < I_IN; r += ngw) conv_weight<ZSPLIT ? 2 : 0>(pp->in[3] + (size_t)l * DM * DIN, DM, DIN, DIN_PAD, (u16*)(ws + WS_WIN) + (size_t)l * DIN_PAD * DM, scr, r, lane);
        for (int r = (gw + ngw - o1) % ngw; r < I_OUT; r += ngw) conv_weight<0>(pp->in[15] + (size_t)l * DM * DM, DM, DM, DM, (u16*)(ws + WS_WOUT) + (size_t)l * DM * DM, scr, r, lane);
        for (int r = (gw + ngw - o2) % ngw; r < I_F1; r += ngw) conv_weight<1>(pp->in[18] + (size_t)l * DM * 2 * DFF, DM, 2 * DFF, 2 * DFF, (u16*)(ws + WS_WF1) + (size_t)l * 2 * DFF * DM, scr, r, lane);
        for (int r = (gw + ngw - o3) % ngw; r < I_F2; r += ngw) conv_weight<0>(pp->in[19] + (size_t)l * DFF * DM, DFF, DM, DM, (u16*)(ws + WS_WF2) + (size_t)l * DM * DFF, scr, r, lane);
    }
    { u16* wt = (u16*)(ws + WS_LRUW);
      for (int idx = gt; idx < DEPTH * 2 * 2 * 4 * 4096; idx += ngt) {
          const int i = idx & 63, j = (idx >> 6) & 63, h = (idx >> 12) & 3, e = (idx >> 14) & 1, mat = (idx >> 15) & 1, l = idx >> 16;
          const float* W = mat ? pp->in[12] : pp->in[10];
          wt[idx] = (u16)f2bf(W[((((size_t)l * 2 + e) * 4 + h) * 64 + i) * 64 + j]); } }
    { float2* tab = (float2*)(ws + WS_ROPE);
      for (int idx = gt; idx < L_SEQ * 32; idx += ngt) { const int pos = idx >> 5, i = idx & 31;
          const float inv = powf(10000.f, -(float)(2 * i) / 64.f); const float ang = (float)pos * inv; float s, c; sincosf(ang, &s, &c); tab[idx] = make_float2(c, s); } }
    row_pass(0, pp->in[0], nullptr, nullptr, nullptr, pp->in[1], (u16*)(ws + WS_H), gw, ngw, lane);
}

constexpr int ATT_HALF_BYTES = 6 * 64 * LP * 2 + 2048;
__device__ __forceinline__ void rope8(u32x4& lo, u32x4& hi, const float2* tab) {
    float a[8], b[8], oa[8], ob[8]; UNPACK8(lo, a); UNPACK8(hi, b);
#pragma unroll
    for (int i = 0; i < 8; ++i) { const float2 cs = tab[i]; oa[i] = a[i] * cs.x - b[i] * cs.y; ob[i] = b[i] * cs.x + a[i] * cs.y; }
    PACK8(lo, oa); PACK8(hi, ob);
}
#define VT_SCATTER(dst, v) do { (dst)[0 * LP] = (u16)((v).x & 0xffff); (dst)[1 * LP] = (u16)((v).x >> 16); (dst)[2 * LP] = (u16)((v).y & 0xffff); (dst)[3 * LP] = (u16)((v).y >> 16); \
    (dst)[4 * LP] = (u16)((v).z & 0xffff); (dst)[5 * LP] = (u16)((v).z >> 16); (dst)[6 * LP] = (u16)((v).w & 0xffff); (dst)[7 * LP] = (u16)((v).w >> 16); } while (0)
template <int TYPE>
__device__ __forceinline__ void attn_unit(int layer, int uidx, unsigned char* hl, int ht) {
    PP pp = get_pp();
    const int lane = ht & 63, hw = __builtin_amdgcn_readfirstlane(ht >> 6), fr = lane & 15, fq = lane >> 4;
    u16* Qs = (u16*)hl; u16* Ks = Qs + 2 * 64 * LP; float* Bs = (float*)(Ks + 4 * 64 * LP);
    u16* Ps = Qs;
    const u16* pbuf = (const u16*)(pp->ws + WS_P);
    const float2* rtab = (const float2*)(pp->ws + WS_ROPE);
    constexpr float LOG2E = 1.4426950408889634f;
    int b, h, r = 0, rsA = 0, rsB = 0, dil = 1, nb = 128, rho = 0, jb = 0, br = 0;
    if (TYPE == 0) { b = uidx >> 8; h = (uidx >> 6) & 3; r = 2 * (uidx & 63); rsA = min(max(r - 4, 0), 120); rsB = min(max(r - 3, 0), 120); }
    else { br = uidx >> 9; const int rem = uidx & 511; b = rem >> 8; h = (rem >> 6) & 3; const int w = rem & 63; dil = (br == 0) ? 1 : (br == 1 ? 4 : 16); nb = 128 / dil; const int nbp = nb >> 1; rho = w / nbp; jb = 2 * (w % nbp); }
    const int qstr = (TYPE == 0) ? 1 : dil;
    const int qtokA = (TYPE == 0) ? r * 64 : rho + dil * 64 * jb; const int qtokB = qtokA + 64 * qstr;
    const size_t rowbase = (size_t)b * L_SEQ;
    const int qcol = ((TYPE == 0) ? C_QB : C_QD) + h * 64;
    const int nkb = (TYPE == 0) ? 9 : 4;
    const int srow = ht >> 2, sc = ht & 3;
    const int vkp = ht >> 3, vdc = ht & 7;
#define KB_INFO(kb_, ktok0_, valid_) do { if (TYPE == 0) { const int kr_ = rsA + (kb_); valid_ = (kr_ <= rsB + 7); ktok0_ = kr_ * 64; } \
        else { const int kj_ = jb - 1 + (kb_); valid_ = (kj_ >= 0 && kj_ < nb); ktok0_ = rho + dil * 64 * kj_; } } while (0)
#define KV_PREFETCH(kt0_) do { const int tok_ = (kt0_) + qstr * srow; const u16* src_ = pbuf + (rowbase + tok_) * DIN + qcol + 256; \
        klo = *(const u32x4*)(src_ + 8 * sc); khi = *(const u32x4*)(src_ + 32 + 8 * sc); \
        if (TYPE == 1) { const f32x4* ct_ = (const f32x4*)(rtab + (size_t)tok_ * 32 + 8 * sc); pcs[0] = ct_[0]; pcs[1] = ct_[1]; pcs[2] = ct_[2]; pcs[3] = ct_[3]; } \
        const u16* vs_ = pbuf + (rowbase + (kt0_) + qstr * 2 * vkp) * DIN + qcol + 512 + 8 * vdc; va = *(const u32x4*)vs_; vb = *(const u32x4*)(vs_ + (size_t)qstr * DIN); } while (0)
    u32x4 klo, khi, va, vb; f32x4 pcs[4]; bool pvalid;
#define KV_STAGE(bufi_) do { u16* Kd_ = Ks + (bufi_) * (2 * 64 * LP); u16* Vd_ = Kd_ + 64 * LP; \
        if (TYPE == 1) { float a_[8], c_[8], oa_[8], ob_[8]; UNPACK8(klo, a_); UNPACK8(khi, c_); \
            _Pragma("unroll") for (int i_ = 0; i_ < 4; ++i_) { const f32x4 cs_ = pcs[i_]; \
                oa_[2 * i_] = a_[2 * i_] * cs_.x - c_[2 * i_] * cs_.y; ob_[2 * i_] = c_[2 * i_] * cs_.x + a_[2 * i_] * cs_.y; \
                oa_[2 * i_ + 1] = a_[2 * i_ + 1] * cs_.z - c_[2 * i_ + 1] * cs_.w; ob_[2 * i_ + 1] = c_[2 * i_ + 1] * cs_.z + a_[2 * i_ + 1] * cs_.w; } \
            PACK8(klo, oa_); PACK8(khi, ob_); } \
        *(u32x4*)(Kd_ + srow * LP + 8 * sc) = klo; *(u32x4*)(Kd_ + srow * LP + 32 + 8 * sc) = khi; \
        unsigned* vt_ = (unsigned*)(Vd_ + (8 * vdc) * LP + 2 * vkp); \
        vt_[0 * (LP / 2)] = (va.x & 0xffffu) | (vb.x << 16); vt_[1 * (LP / 2)] = (va.x >> 16) | (vb.x & 0xffff0000u); \
        vt_[2 * (LP / 2)] = (va.y & 0xffffu) | (vb.y << 16); vt_[3 * (LP / 2)] = (va.y >> 16) | (vb.y & 0xffff0000u); \
        vt_[4 * (LP / 2)] = (va.z & 0xffffu) | (vb.z << 16); vt_[5 * (LP / 2)] = (va.z >> 16) | (vb.z & 0xffff0000u); \
        vt_[6 * (LP / 2)] = (va.w & 0xffffu) | (vb.w << 16); vt_[7 * (LP / 2)] = (va.w >> 16) | (vb.w & 0xffff0000u); } while (0)
    { int kt0; KB_INFO(0, kt0, pvalid); if (pvalid) { KV_PREFETCH(kt0); } }
    __syncthreads();
#pragma unroll
    for (int tq = 0; tq < 2; ++tq) { const int tok = (tq ? qtokB : qtokA) + qstr * srow; const u16* src = pbuf + (rowbase + tok) * DIN + qcol;
      u32x4 lo = *(const u32x4*)(src + 8 * sc), hi = *(const u32x4*)(src + 32 + 8 * sc);
      if (TYPE == 1) rope8(lo, hi, rtab + (size_t)tok * 32 + 8 * sc);
      *(u32x4*)(Qs + (tq * 64 + srow) * LP + 8 * sc) = lo; *(u32x4*)(Qs + (tq * 64 + srow) * LP + 32 + 8 * sc) = hi; }
    if (TYPE == 0) { const float* rpb = pp->in[7] + (size_t)(layer * 4 + h) * 465; for (int i = ht; i < 465; i += 256) Bs[i] = rpb[i] * LOG2E; }
    bool cvalid = pvalid;
    if (pvalid) { KV_STAGE(0); }
    { int kt0; KB_INFO(1, kt0, pvalid); if (pvalid) { KV_PREFETCH(kt0); } }
    const int qi = 16 * hw + fr;
    unsigned okm = 0xffffu; int bofs[16];
#pragma unroll
    for (int n = 0; n < 4; ++n)
#pragma unroll
        for (int j = 0; j < 4; ++j) { const int kj = 16 * n + 4 * fq + j;
            if (TYPE == 0) { const int cs = min(max(qi - 8, 0), 48); if (!((kj >= cs) && (kj < cs + 16))) okm &= ~(1u << (4 * n + j)); bofs[4 * n + j] = min(max(kj - qi, -15), 15) + 15; }
            else bofs[4 * n + j] = 0; }
    f32x4 o[2][4]; float mrow[2], lrow[2];
#pragma unroll
    for (int tq = 0; tq < 2; ++tq) { mrow[tq] = -INFINITY; lrow[tq] = 0.f;
#pragma unroll
        for (int i = 0; i < 4; ++i) o[tq][i] = (f32x4){0.f, 0.f, 0.f, 0.f}; }
    __syncthreads();
    bf16x8 aq[2][2];
#pragma unroll
    for (int tq = 0; tq < 2; ++tq) { aq[tq][0] = ldfrag(Qs + (tq * 64 + qi) * LP + fq * 8); aq[tq][1] = ldfrag(Qs + (tq * 64 + qi) * LP + 32 + fq * 8); }
    asm volatile("s_waitcnt lgkmcnt(0)" ::: "memory");
    const bool stag = (ht != (int)threadIdx.x);
    bool nvalid = false;
#define STAGE_NEXT() do { if (kb + 1 < nkb) { if (pvalid) { KV_STAGE((kb + 1) & 1); } nvalid = pvalid; \
        if (kb + 2 < nkb) { int kt0_; KB_INFO(kb + 2, kt0_, pvalid); if (pvalid) { KV_PREFETCH(kt0_); } } } } while (0)
#pragma unroll 2
    for (int kb = 0; kb < nkb; ++kb) {
        const u16* Kc = Ks + (kb & 1) * (2 * 64 * LP); const u16* Vc = Kc + 64 * LP;
        if (stag) { STAGE_NEXT(); }
        if (cvalid) {
#pragma unroll
            for (int tq = 0; tq < 2; ++tq) {
                bool act; int delta = 0, dr = 0;
                if (TYPE == 0) { const int krow = rsA + kb; const int rq = r + tq; const int rsq = tq ? rsB : rsA; act = (krow >= rsq) && (krow <= rsq + 7); dr = krow - rq; }
                else { delta = kb - 1 - tq; act = (delta >= -1) && (delta <= 1); }
                int ntlo = 0, nthi = 3;
                if (TYPE == 0) { const int klo_ = min(max(16 * hw - 8, 0), 48), khi_ = min(max(16 * hw + 15 - 8, 0), 48) + 15; ntlo = klo_ >> 4; nthi = khi_ >> 4; }
                else { if (delta < 0) ntlo = hw; else if (delta > 0) nthi = hw; }
                if (act) {
                    float bsv[16];
#pragma unroll
                    for (int i = 0; i < 16; ++i) bsv[i] = (TYPE == 0) ? Bs[(dr + 7) * 31 + bofs[i]] : 0.f;
                    f32x4 s[4];
#pragma unroll
                    for (int n = 0; n < 4; ++n) { s[n] = (f32x4){0.f, 0.f, 0.f, 0.f};
                        if (n >= ntlo && n <= nthi) {
                            s[n] = mfma16(ldfrag(Kc + (16 * n + fr) * LP + fq * 8), aq[tq][0], s[n]);
                            s[n] = mfma16(ldfrag(Kc + (16 * n + fr) * LP + 32 + fq * 8), aq[tq][1], s[n]); } }
                    float mx = -INFINITY;
#pragma unroll
                    for (int n = 0; n < 4; ++n)
#pragma unroll
                        for (int j = 0; j < 4; ++j) { const int kj = 16 * n + 4 * fq + j; bool ok; float v = s[n][j] * (0.125f * LOG2E);
                            if (TYPE == 0) { ok = (okm >> (4 * n + j)) & 1u; v += bsv[4 * n + j]; }
                            else { ok = (delta == 0) ? true : (delta < 0 ? (kj >= qi) : (kj <= qi)); }
                            v = ok ? v : -INFINITY; s[n][j] = v; mx = fmaxf(mx, v); }
                    mx = fmaxf(mx, __shfl_xor(mx, 16)); mx = fmaxf(mx, __shfl_xor(mx, 32));
                    const float mnew = fmaxf(mrow[tq], mx);
                    const float msafe = (mnew == -INFINITY) ? 0.f : mnew;
                    const float alpha = __builtin_amdgcn_exp2f(mrow[tq] - msafe);
                    float sum = 0.f;
#pragma unroll
                    for (int n = 0; n < 4; ++n) { float p[4];
#pragma unroll
                        for (int j = 0; j < 4; ++j) { p[j] = __builtin_amdgcn_exp2f(s[n][j] - msafe); sum += p[j]; }
                        uint2 w; w.x = cvtpk(p[0], p[1]); w.y = cvtpk(p[2], p[3]);
                        *(uint2*)(Ps + (tq * 64 + qi) * LP + 16 * n + 4 * fq) = w; }
                    sum += __shfl_xor(sum, 16); sum += __shfl_xor(sum, 32);
                    lrow[tq] = lrow[tq] * alpha + sum; mrow[tq] = mnew;
#pragma unroll
                    for (int nd = 0; nd < 4; ++nd) o[tq][nd] = o[tq][nd] * alpha;
                }
            }
            asm volatile("s_waitcnt lgkmcnt(0)" ::: "memory");
#pragma unroll
            for (int tq = 0; tq < 2; ++tq) {
                bool act; int delta = 0;
                if (TYPE == 0) { const int krow = rsA + kb; const int rsq = tq ? rsB : rsA; act = (krow >= rsq) && (krow <= rsq + 7); }
                else { delta = kb - 1 - tq; act = (delta >= -1) && (delta <= 1); }
                int ntlo = 0, nthi = 3;
                if (TYPE == 0) { const int klo_ = min(max(16 * hw - 8, 0), 48), khi_ = min(max(16 * hw + 15 - 8, 0), 48) + 15; ntlo = klo_ >> 4; nthi = khi_ >> 4; }
                else { if (delta < 0) ntlo = hw; else if (delta > 0) nthi = hw; }
                if (act) {
#pragma unroll
                    for (int kk = 0; kk < 2; ++kk) if (2 * kk + 1 >= ntlo && 2 * kk <= nthi) { const bf16x8 bp = ldfrag(Ps + (tq * 64 + qi) * LP + 32 * kk + fq * 8);
#pragma unroll
                        for (int nd = 0; nd < 4; ++nd) o[tq][nd] = mfma16(ldfrag(Vc + (16 * nd + fr) * LP + 32 * kk + fq * 8), bp, o[tq][nd]); }
                }
            }
        }
        if (!stag) { STAGE_NEXT(); }
        __syncthreads();
        cvalid = nvalid;
    }
#undef STAGE_NEXT
#undef KV_STAGE
#undef KB_INFO
#undef KV_PREFETCH
#pragma unroll
    for (int tq = 0; tq < 2; ++tq) { const int tok = (tq ? qtokB : qtokA) + qstr * qi; const float inv = rcpf_(lrow[tq]);
      u16* dst = (TYPE == 0) ? (u16*)(pp->ws + WS_H) + (rowbase + tok) * DM + 256 + h * 64 : (u16*)(pp->ws + WS_DAP) + ((size_t)br * MTOK + rowbase + tok) * 256 + h * 64;
#pragma unroll
      for (int nd = 0; nd < 4; ++nd) { uint2 w; w.x = cvtpk(o[tq][nd][0] * inv, o[tq][nd][1] * inv); w.y = cvtpk(o[tq][nd][2] * inv, o[tq][nd][3] * inv);
          *(uint2*)(dst + 16 * nd + 4 * fq) = w; }
      if (TYPE == 1 && fq == 0) ((float*)(pp->ws + WS_DAL))[((size_t)br * MTOK + rowbase + tok) * 4 + h] = (mrow[tq] + __log2f(lrow[tq])) * 0.6931471805599453f; }
}

constexpr int G1_ZS = 0;
constexpr int G1_WG = G1_ZS + 8192;
constexpr int G1_BG = G1_WG + 8192;
constexpr int G1_SEG = G1_BG + 512;
constexpr int G1_LA = G1_SEG + 4096;
constexpr int G1_T = G1_LA + 2 * 64 * FP * 4;
__device__ __forceinline__ void gla1_phase(int layer, unsigned char* lds, int tid, int bid, int G) {
    PP pp = get_pp();
    const int lane = tid & 63, w = __builtin_amdgcn_readfirstlane(tid >> 6), fr = lane & 15, fq = lane >> 4;
    float* ZS = (float*)(lds + G1_ZS); float* WG = (float*)(lds + G1_WG); float* BG = (float*)(lds + G1_BG); float* SEG = (float*)(lds + G1_SEG); float* LA = (float*)(lds + G1_LA);
    u16* KdT = (u16*)(lds + G1_T); u16* Vt = KdT + 2 * 64 * LP;
    const u16* pbuf = (const u16*)(pp->ws + WS_P);
    const int c = tid >> 3, part = tid & 7;
    int hc = -1;
    uint2 zz = make_uint2(0u, 0u); u32x4 kn = (u32x4){0u, 0u, 0u, 0u}, vn = kn;
#define GLA1_PREFETCH(u_) do { const int b_ = (u_) >> 9, n_ = ((u_) >> 2) & 127, h_ = (u_) & 3; const u16* r_ = pbuf + ((size_t)b_ * L_SEQ + n_ * 64 + c) * DIN; \
        zz = *(const uint2*)(r_ + C_ZA + 4 * part); kn = *(const u32x4*)(r_ + C_KA + h_ * 64 + 8 * part); vn = *(const u32x4*)(r_ + C_VA + h_ * 64 + 8 * part); } while (0)
    if (bid < 1024) GLA1_PREFETCH(bid);
#pragma unroll 1
    for (int uidx = bid; uidx < 1024; uidx += G) {
        const int b = uidx >> 9, n = (uidx >> 2) & 127, h = uidx & 3;
        const int sidx = b * 512 + h * 128 + n;
        __syncthreads();
        { float* z = ZS + c * 32 + 4 * part; z[0] = blo(zz.x); z[1] = bhi(zz.x); z[2] = blo(zz.y); z[3] = bhi(zz.y);
          if (h != hc) { hc = h;
#pragma unroll
              for (int q = 0; q < 4; ++q) { const int i = tid + 512 * q; const int e = i >> 10, rr = (i >> 6) & 15, ch = i & 63; WG[i] = pp->in[4][(((size_t)layer * 2 + e) * 16 + rr) * 256 + h * 64 + ch]; }
              if (tid < 128) { const int e = tid >> 6, ch = tid & 63; BG[tid] = pp->in[5][((size_t)layer * 2 + e) * 256 + h * 64 + ch]; } } }
        const u32x4 kv = kn, vv = vn;
        if (uidx + G < 1024) GLA1_PREFETCH(uidx + G);
        __syncthreads();
        const int ch = tid & 63, seg = __builtin_amdgcn_readfirstlane(tid >> 6);
        float la0[8], la1[8];
#pragma unroll
        for (int i = 0; i < 8; ++i) { const int cc = seg * 8 + i; float a0 = BG[ch], a1 = BG[64 + ch];
#pragma unroll
            for (int rr = 0; rr < 16; ++rr) { a0 += ZS[cc * 32 + rr] * WG[rr * 64 + ch]; a1 += ZS[cc * 32 + 16 + rr] * WG[1024 + rr * 64 + ch]; }
            la0[i] = logsigmoidf_(a0) * (1.f / 16.f); la1[i] = logsigmoidf_(a1) * (1.f / 16.f); }
#pragma unroll
        for (int i = 1; i < 8; ++i) la0[i] += la0[i - 1];
#pragma unroll
        for (int i = 6; i >= 0; --i) la1[i] += la1[i + 1];
        SEG[seg * 64 + ch] = la0[7]; SEG[512 + seg * 64 + ch] = la1[0];
        __syncthreads();
        { float pre0 = 0.f, pre1 = 0.f;
#pragma unroll
          for (int s2 = 0; s2 < 8; ++s2) { if (s2 < seg) pre0 += SEG[s2 * 64 + ch]; if (s2 > seg) pre1 += SEG[512 + s2 * 64 + ch]; }
          float* gb0 = (float*)(pp->ws + WS_GB) + (size_t)sidx * 4096; float* gb1 = gb0 + (size_t)1024 * 4096;
#pragma unroll
          for (int i = 0; i < 8; ++i) { const int cc = seg * 8 + i; const float v0 = la0[i] + pre0, v1 = la1[i] + pre1;
              LA[cc * FP + ch] = v0; LA[(64 + cc) * FP + ch] = v1; gb0[cc * 64 + ch] = v0; gb1[cc * 64 + ch] = v1; } }
        __syncthreads();
        if (tid < 128) { const int e = tid >> 6, k = tid & 63; ((float*)(pp->ws + WS_GDEC))[((size_t)e * 1024 + sidx) * 64 + k] = __expf(LA[(e * 64 + (e ? 0 : 63)) * FP + k]); }
        { float kf[8]; UNPACK8(kv, kf);
#pragma unroll
          for (int j = 0; j < 8; ++j) { const int k = 8 * part + j;
              KdT[k * LP + c] = (u16)f2bf(kf[j] * __expf(LA[63 * FP + k] - LA[c * FP + k]));
              KdT[(64 + k) * LP + c] = (u16)f2bf(kf[j] * __expf(LA[64 * FP + k] - LA[(64 + c) * FP + k])); }
          u16* vt = Vt + (8 * part) * LP + c; VT_SCATTER(vt, vv); }
        __syncthreads();
        { const int e = w >> 2, mt = w & 3;
          const bf16x8 a0 = ldfrag(KdT + (e * 64 + 16 * mt + fr) * LP + 8 * fq), a1 = ldfrag(KdT + (e * 64 + 16 * mt + fr) * LP + 32 + 8 * fq);
          float* kvout = (float*)(pp->ws + WS_GLA) + ((size_t)e * 1024 + sidx) * 4096;
#pragma unroll
          for (int nt = 0; nt < 4; ++nt) { f32x4 acc = (f32x4){0.f, 0.f, 0.f, 0.f};
              acc = mfma16(a0, ldfrag(Vt + (16 * nt + fr) * LP + 8 * fq), acc); acc = mfma16(a1, ldfrag(Vt + (16 * nt + fr) * LP + 32 + 8 * fq), acc);
#pragma unroll
              for (int j = 0; j < 4; ++j) kvout[(16 * mt + 4 * fq + j) * 64 + 16 * nt + fr] = acc[j]; } }
    }
#undef GLA1_PREFETCH
}

__device__ __forceinline__ void gla2_scan(int tid, int bid, int G) {
    PP pp = get_pp();
    float* KV = (float*)(pp->ws + WS_GLA); const float* DEC = (const float*)(pp->ws + WS_GDEC);
    if (tid >= 256) return;
    for (int idx = bid * 256 + tid; idx < 16 * 4096; idx += G * 256) {
        const int seq = idx >> 12, kvi = idx & 4095, k = kvi >> 6; const int e = seq >> 3;
        float S = 0.f;
#pragma unroll 32
        for (int i = 0; i < 128; ++i) { const int n = e ? 127 - i : i; const size_t u = (size_t)seq * 128 + n;
            const float t = KV[u * 4096 + kvi]; const float d = DEC[u * 64 + k]; KV[u * 4096 + kvi] = S; S = S * d + t; }
    }
}

constexpr int G3_TB = 64 * LP * 2;
constexpr int G3_OS = 11 * G3_TB;
__device__ __forceinline__ void gla3_phase(int layer, unsigned char* lds, int tid, int bid, int G) {
    PP pp = get_pp();
    const int lane = tid & 63, w = __builtin_amdgcn_readfirstlane(tid >> 6), fr = lane & 15, fq = lane >> 4;
    u16* T = (u16*)lds;
    u16* Vt = T + 10 * 64 * LP; float* OS = (float*)(lds + G3_OS);
    const u16* pbuf = (const u16*)(pp->ws + WS_P);
    const int c = tid >> 3, kc = tid & 7;
    u32x4 qn, kn, vn, gn; f32x4 bn[2][2], mn[2][2], sn[2][2];
#define GLA3_PREFETCH(u_) do { const int b_ = (u_) >> 9, n_ = ((u_) >> 2) & 127, h_ = (u_) & 3; const int s_ = b_ * 512 + h_ * 128 + n_; \
        const u16* r_ = pbuf + ((size_t)b_ * L_SEQ + n_ * 64 + c) * DIN + h_ * 64 + 8 * kc; \
        qn = *(const u32x4*)(r_ + C_QA); kn = *(const u32x4*)(r_ + C_KA); vn = *(const u32x4*)(r_ + C_VA); gn = *(const u32x4*)(r_ + C_GA); \
        _Pragma("unroll") for (int e_ = 0; e_ < 2; ++e_) { const float* gb_ = (const float*)(pp->ws + WS_GB) + ((size_t)e_ * 1024 + s_) * 4096; const float* sg_ = (const float*)(pp->ws + WS_GLA) + ((size_t)e_ * 1024 + s_) * 4096; \
            bn[e_][0] = __builtin_nontemporal_load((const f32x4*)(gb_ + c * 64 + 8 * kc)); bn[e_][1] = __builtin_nontemporal_load((const f32x4*)(gb_ + c * 64 + 8 * kc + 4)); \
            mn[e_][0] = *(const f32x4*)(gb_ + 32 * 64 + 8 * kc); mn[e_][1] = *(const f32x4*)(gb_ + 32 * 64 + 8 * kc + 4); \
            sn[e_][0] = __builtin_nontemporal_load((const f32x4*)(sg_ + c * 64 + 8 * kc)); sn[e_][1] = __builtin_nontemporal_load((const f32x4*)(sg_ + c * 64 + 8 * kc + 4)); } } while (0)
    if (bid < 1024) GLA3_PREFETCH(bid);
#pragma unroll 1
    for (int uidx = bid; uidx < 1024; uidx += G) {
        const int b = uidx >> 9, n = (uidx >> 2) & 127, h = uidx & 3;
        const size_t tok0 = (size_t)b * L_SEQ + n * 64;
        __syncthreads();
        { float qf[8], kf[8]; UNPACK8(qn, qf); UNPACK8(kn, kf);
#pragma unroll
          for (int e = 0; e < 2; ++e) {
              const f32x4 b0 = bn[e][0], b1 = bn[e][1], m0 = mn[e][0], m1 = mn[e][1];
              const float bv[8] = {b0.x, b0.y, b0.z, b0.w, b1.x, b1.y, b1.z, b1.w}; const float bm[8] = {m0.x, m0.y, m0.z, m0.w, m1.x, m1.y, m1.z, m1.w};
              float a[8], bb[8], cc[8];
#pragma unroll
              for (int j = 0; j < 8; ++j) { a[j] = qf[j] * 0.125f * __expf(bv[j] - bm[j]); bb[j] = kf[j] * __expf(bm[j] - bv[j]); cc[j] = qf[j] * 0.125f * __expf(bv[j]); }
              u32x4 o; PACK8(o, a); *(u32x4*)(T + ((0 + e) * 64 + c) * LP + 8 * kc) = o; PACK8(o, bb); *(u32x4*)(T + ((2 + e) * 64 + c) * LP + 8 * kc) = o; PACK8(o, cc); *(u32x4*)(T + ((4 + e) * 64 + c) * LP + 8 * kc) = o;
              const f32x4 s0 = sn[e][0], s1 = sn[e][1];
              u16* st = T + ((6 + e) * 64 + 8 * kc) * LP + c;
              st[0 * LP] = (u16)f2bf(s0.x); st[1 * LP] = (u16)f2bf(s0.y); st[2 * LP] = (u16)f2bf(s0.z); st[3 * LP] = (u16)f2bf(s0.w);
              st[4 * LP] = (u16)f2bf(s1.x); st[5 * LP] = (u16)f2bf(s1.y); st[6 * LP] = (u16)f2bf(s1.z); st[7 * LP] = (u16)f2bf(s1.w); }
          u16* vt = Vt + (8 * kc) * LP + c; VT_SCATTER(vt, vn); }
        const u32x4 gcur = gn;
        if (uidx + G < 1024) GLA3_PREFETCH(uidx + G);
        __syncthreads();
        { const int e = w >> 2, mt = w & 3;
          const u16* Qe = T + (0 + e) * 64 * LP; const u16* Ke = T + (2 + e) * 64 * LP; u16* At = T + (8 + e) * 64 * LP;
          const bf16x8 a0 = ldfrag(Qe + (16 * mt + fr) * LP + 8 * fq), a1 = ldfrag(Qe + (16 * mt + fr) * LP + 32 + 8 * fq);
#pragma unroll
          for (int nt = 0; nt < 4; ++nt) { f32x4 acc = (f32x4){0.f, 0.f, 0.f, 0.f};
              acc = mfma16(a0, ldfrag(Ke + (16 * nt + fr) * LP + 8 * fq), acc); acc = mfma16(a1, ldfrag(Ke + (16 * nt + fr) * LP + 32 + 8 * fq), acc);
#pragma unroll
              for (int j = 0; j < 4; ++j) { const int cq = 16 * mt + 4 * fq + j, s = 16 * nt + fr; const bool ok = (e == 0) ? (s <= cq) : (s >= cq);
                  At[cq * LP + s] = (u16)f2bf(ok ? acc[j] : 0.f); } } }
        __syncthreads();
        { const int mt = w >> 1;
          f32x4 oacc[2]; oacc[0] = (f32x4){0.f, 0.f, 0.f, 0.f}; oacc[1] = oacc[0];
#pragma unroll
          for (int e = 0; e < 2; ++e) { const u16* At = T + (8 + e) * 64 * LP; const u16* Qb = T + (4 + e) * 64 * LP; const u16* St = T + (6 + e) * 64 * LP;
#pragma unroll
              for (int kk = 0; kk < 2; ++kk) { const bf16x8 aA = ldfrag(At + (16 * mt + fr) * LP + 32 * kk + 8 * fq), aQ = ldfrag(Qb + (16 * mt + fr) * LP + 32 * kk + 8 * fq);
#pragma unroll
                  for (int t = 0; t < 2; ++t) { const int nt = (w & 1) * 2 + t;
                      oacc[t] = mfma16(aA, ldfrag(Vt + (16 * nt + fr) * LP + 32 * kk + 8 * fq), oacc[t]);
                      oacc[t] = mfma16(aQ, ldfrag(St + (16 * nt + fr) * LP + 32 * kk + 8 * fq), oacc[t]); } } }
#pragma unroll
          for (int t = 0; t < 2; ++t) { const int nt = (w & 1) * 2 + t;
#pragma unroll
              for (int j = 0; j < 4; ++j) OS[(16 * mt + 4 * fq + j) * FP + 16 * nt + fr] = oacc[t][j]; } }
        __syncthreads();
        { float ov[8]; float ss = 0.f;
#pragma unroll
          for (int j = 0; j < 8; ++j) { ov[j] = OS[c * FP + 8 * kc + j]; ss += ov[j] * ov[j]; }
          ss += __shfl_xor(ss, 1); ss += __shfl_xor(ss, 2); ss += __shfl_xor(ss, 4);
          const float rs = rsqrtf(ss * (1.f / 64.f) + EPS);
          float gf[8]; UNPACK8(gcur, gf);
          const float* ng = pp->in[6] + (size_t)layer * 256 + h * 64 + 8 * kc;
#pragma unroll
          for (int j = 0; j < 8; ++j) ov[j] = ov[j] * rs * ng[j] * (gf[j] * sigmoidf_(gf[j]));
          u32x4 o; PACK8(o, ov);
          *(u32x4*)((u16*)(pp->ws + WS_H) + (tok0 + c) * DM + h * 64 + 8 * kc) = o; }
    }
#undef GLA3_PREFETCH
}

constexpr int LR_XF = 0;
constexpr int LR_XB = LR_XF + 64 * FP * 4;
constexpr int LR_A = LR_XB + 64 * LP * 2;
constexpr int LR_U = LR_A + 2 * 64 * FP * 4;
constexpr int LR_END = LR_U + 2 * 64 * FP * 4;
template <int PASS>
__device__ __forceinline__ void lru_phase(int layer, unsigned char* lds, int tid, int bid, int G) {
    PP pp = get_pp();
    const int lane = tid & 63, w = __builtin_amdgcn_readfirstlane(tid >> 6), fr = lane & 15, fq = lane >> 4;
    float* XF = (float*)(lds + LR_XF); u16* XB = (u16*)(lds + LR_XB); float* AS = (float*)(lds + LR_A); float* US = (float*)(lds + LR_U);
    const u16* pbuf = (const u16*)(pp->ws + WS_P);
    const int t = tid >> 3, cc = tid & 7;
    const int mt = w & 3, e = w >> 2;
    int hc = -1;
    bf16x8 wa[4][2], wx[4][2]; float ba[4], bx[4], sp[4], cw[4][8], cb[8];
    u32x4 xt[4], gnext = (u32x4){0u, 0u, 0u, 0u};
#define LRU_PREFETCH(u_) do { const int b_ = (u_) >> 9, n_ = ((u_) >> 2) & 127, h_ = (u_) & 3; const size_t rb_ = (size_t)b_ * L_SEQ; \
        _Pragma("unroll") for (int jj = 0; jj < 4; ++jj) { const int tt_ = n_ * 64 + t - 2 + jj; \
            xt[jj] = (tt_ >= 0 && tt_ < L_SEQ) ? *(const u32x4*)(pbuf + (rb_ + tt_) * DIN + C_XC + h_ * 64 + 8 * cc) : (u32x4){0u, 0u, 0u, 0u}; } \
        if (PASS == 3) gnext = *(const u32x4*)(pbuf + (rb_ + n_ * 64 + t) * DIN + C_GC + h_ * 64 + 8 * cc); } while (0)
    if (bid < 1024) LRU_PREFETCH(bid);
#pragma unroll 1
    for (int uidx = bid; uidx < 1024; uidx += G) {
        const int b = uidx >> 9, n = (uidx >> 2) & 127, h = uidx & 3;
        const size_t rowbase = (size_t)b * L_SEQ; const int t0 = n * 64;
        if (h != hc) { hc = h;
            const u16* WA = (const u16*)(pp->ws + WS_LRUW) + ((((size_t)layer * 2 + 0) * 2 + e) * 4 + h) * 4096;
            const u16* WX = (const u16*)(pp->ws + WS_LRUW) + ((((size_t)layer * 2 + 1) * 2 + e) * 4 + h) * 4096;
#pragma unroll
            for (int nt = 0; nt < 4; ++nt) { const int jc = 16 * nt + fr; const int chg = h * 64 + jc;
                wa[nt][0] = ldfrag(WA + jc * 64 + 8 * fq); wa[nt][1] = ldfrag(WA + jc * 64 + 32 + 8 * fq);
                wx[nt][0] = ldfrag(WX + jc * 64 + 8 * fq); wx[nt][1] = ldfrag(WX + jc * 64 + 32 + 8 * fq);
                ba[nt] = pp->in[11][((size_t)layer * 2 + e) * 256 + chg]; bx[nt] = pp->in[13][((size_t)layer * 2 + e) * 256 + chg];
                sp[nt] = softplusf_(-pp->in[14][((size_t)layer * 2 + e) * 256 + chg]); }
#pragma unroll
            for (int j = 0; j < 8; ++j) { cb[j] = pp->in[9][(size_t)layer * 256 + h * 64 + 8 * cc + j];
#pragma unroll
                for (int jj = 0; jj < 4; ++jj) cw[jj][j] = pp->in[8][((size_t)layer * 4 + jj) * 256 + h * 64 + 8 * cc + j]; } }
        __syncthreads();
        { float acc[8];
#pragma unroll
          for (int j = 0; j < 8; ++j) acc[j] = cb[j];
#pragma unroll
          for (int jj = 0; jj < 4; ++jj) { float xf[8]; UNPACK8(xt[jj], xf);
#pragma unroll
              for (int j = 0; j < 8; ++j) acc[j] += xf[j] * cw[jj][j]; }
#pragma unroll
          for (int j = 0; j < 8; ++j) XF[t * FP + 8 * cc + j] = acc[j];
          u32x4 o; PACK8(o, acc); *(u32x4*)(XB + t * LP + 8 * cc) = o; }
        const u32x4 gcur = gnext;
        float hin = 0.f; size_t cidx = 0;
        if (tid < 128) { const int e2 = tid >> 6, ch = tid & 63; cidx = ((size_t)(e2 * 2 + b) * 128 + n) * 256 + h * 64 + ch; if (PASS == 3) hin = ((const float*)(pp->ws + WS_LRUH))[cidx]; }
        if (uidx + G < 1024) LRU_PREFETCH(uidx + G);
        __syncthreads();
        { const bf16x8 a0 = ldfrag(XB + (16 * mt + fr) * LP + 8 * fq), a1 = ldfrag(XB + (16 * mt + fr) * LP + 32 + 8 * fq);
#pragma unroll
          for (int nt = 0; nt < 4; ++nt) { const int jc = 16 * nt + fr;
              f32x4 ar = (f32x4){0.f, 0.f, 0.f, 0.f}, ai = ar;
              ar = mfma16(a0, wa[nt][0], ar); ar = mfma16(a1, wa[nt][1], ar);
              ai = mfma16(a0, wx[nt][0], ai); ai = mfma16(a1, wx[nt][1], ai);
#pragma unroll
              for (int j = 0; j < 4; ++j) { const int tt = 16 * mt + 4 * fq + j;
                  const float rg = sigmoidf_(ar[j] + ba[nt]), ig = sigmoidf_(ai[j] + bx[nt]);
                  const float la = -8.f * rg * sp[nt]; const float a = __expf(la); const float u = __builtin_amdgcn_sqrtf(fmaxf(1.f - a * a, 0.f)) * (ig * XF[tt * FP + jc]);
                  AS[(e * 64 + tt) * FP + jc] = a; US[(e * 64 + tt) * FP + jc] = u; } } }
        __syncthreads();
        if (tid < 128) { const int e2 = tid >> 6, ch = tid & 63;
            if (PASS == 1) { float Pp = 1.f, H = 0.f;
#pragma unroll 16
                for (int i = 0; i < 64; ++i) { const int tt = e2 ? 63 - i : i; const float a = AS[(e2 * 64 + tt) * FP + ch], u = US[(e2 * 64 + tt) * FP + ch]; Pp *= a; H = a * H + u; }
                ((float*)(pp->ws + WS_LRUA))[cidx] = Pp; ((float*)(pp->ws + WS_LRUH))[cidx] = H; }
            else { float H = hin;
#pragma unroll 16
                for (int i = 0; i < 64; ++i) { const int tt = e2 ? 63 - i : i; const float a = AS[(e2 * 64 + tt) * FP + ch], u = US[(e2 * 64 + tt) * FP + ch]; H = a * H + u; US[(e2 * 64 + tt) * FP + ch] = H; } } }
        if (PASS == 3) {
            __syncthreads();
            float gf[8], ov[8]; UNPACK8(gcur, gf);
#pragma unroll
            for (int j = 0; j < 8; ++j) ov[j] = (US[t * FP + 8 * cc + j] + US[(64 + t) * FP + 8 * cc + j]) * gelu_tanh(gf[j]);
            u32x4 o; PACK8(o, ov);
            *(u32x4*)((u16*)(pp->ws + WS_H) + (rowbase + t0 + t) * DM + 512 + h * 64 + 8 * cc) = o;
        }
    }
#undef LRU_PREFETCH
}
__device__ __forceinline__ void lru2_scan(int tid, int bid, int G) {
    PP pp = get_pp();
    const float* A = (const float*)(pp->ws + WS_LRUA); float* Hh = (float*)(pp->ws + WS_LRUH);
    if (tid < 256) return;
    for (int idx = (tid - 256) * G + bid; idx < 2 * 2 * 256; idx += 256 * G) { const int ch = idx & 255, eb = idx >> 8, e = eb >> 1;
        float H = 0.f;
#pragma unroll 32
        for (int i = 0; i < 128; ++i) { const int n = e ? 127 - i : i; const size_t c = ((size_t)eb * 128 + n) * 256 + ch; const float a = A[c], hl = Hh[c]; Hh[c] = H; H = a * H + hl; } }
}
__device__ __forceinline__ void da_combine(int gt, int ngt) {
    PP pp = get_pp();
    const u16* dap = (const u16*)(pp->ws + WS_DAP); const float* dal = (const float*)(pp->ws + WS_DAL); u16* y = (u16*)(pp->ws + WS_H);
    constexpr int NI = 4;
    for (int idx0 = gt; idx0 < MTOK * 32; idx0 += NI * ngt) {
        u32x4 v[NI][3]; float l[NI][3]; bool has[NI]; int tok[NI], c[NI];
#pragma unroll
        for (int q = 0; q < NI; ++q) { const int idx = idx0 + q * ngt; has[q] = idx < MTOK * 32; const int id2 = has[q] ? idx : idx0; tok[q] = id2 >> 5; c[q] = id2 & 31; const int h = c[q] >> 3;
#pragma unroll
            for (int g = 0; g < 3; ++g) { l[q][g] = dal[((size_t)g * MTOK + tok[q]) * 4 + h]; v[q][g] = __builtin_nontemporal_load((const u32x4*)(dap + ((size_t)g * MTOK + tok[q]) * 256 + 8 * c[q])); } }
#pragma unroll
        for (int q = 0; q < NI; ++q) {
            const float mx = fmaxf(l[q][0], fmaxf(l[q][1], l[q][2])); float w0 = __expf(l[q][0] - mx), w1 = __expf(l[q][1] - mx), w2 = __expf(l[q][2] - mx); const float inv = rcpf_(w0 + w1 + w2); w0 *= inv; w1 *= inv; w2 *= inv;
            float f0[8], f1[8], f2[8], ov[8]; UNPACK8(v[q][0], f0); UNPACK8(v[q][1], f1); UNPACK8(v[q][2], f2);
#pragma unroll
            for (int j = 0; j < 8; ++j) ov[j] = w0 * f0[j] + w1 * f1[j] + w2 * f2[j];
            u32x4 o; PACK8(o, ov);
            if (has[q]) *(u32x4*)(y + (size_t)tok[q] * DM + 768 + 8 * c[q]) = o; }
    }
}

#define LAS __attribute__((address_space(3)))
#define XB_TMO      128
#define XB_XCNT(j)  (256  + 64 * (j))
#define XB_XSUB(j)  (1280 + 64 * (j))
#define XB_XGEN(j)  (2304 + 64 * (j))
#define XB_TOP      3328
#define XB_TOPGEN   3392
#define XCD_BAR_WORDS 3456
#define XB_SPIN_CAP (1u << 18)

__device__ __forceinline__ unsigned xb_ld(unsigned* p)              { return __hip_atomic_load(p, __ATOMIC_RELAXED, __HIP_MEMORY_SCOPE_AGENT); }
__device__ __forceinline__ unsigned xb_add(unsigned* p, unsigned v) { return __hip_atomic_fetch_add(p, v, __ATOMIC_RELAXED, __HIP_MEMORY_SCOPE_AGENT); }
__device__ __forceinline__ unsigned xb_xcc_id() { return (unsigned)__builtin_amdgcn_s_getreg((3 << 11) | 20) & 0xFu; }
#define XB_SPIN(cond, bar) do { unsigned _sp = 0; while (cond) { __builtin_amdgcn_s_sleep(1); \
    if ((++_sp & 255u) == 0u) { if (xb_ld(&(bar)[XB_TMO])) break; if (_sp > XB_SPIN_CAP) { atomicAdd(&(bar)[XB_TMO], 1u); break; } } } } while (0)

struct XcdBarrier {
    unsigned* bar; unsigned x;
    volatile LAS unsigned* st;
};

__device__ __forceinline__ XcdBarrier xcd_barrier_post(unsigned* bar, volatile LAS unsigned* st) {
    XcdBarrier b; b.bar = bar; b.x = xb_xcc_id(); b.st = st;
    if (threadIdx.x == 0) (void)xb_add(&bar[XB_XCNT(b.x)], 1u);
    return b;
}
__device__ __forceinline__ void xcd_barrier_complete(unsigned* bar, unsigned x, unsigned& nloc, unsigned& nx) {
    const unsigned G = gridDim.x * gridDim.y * gridDim.z;
    unsigned sum, cnt, mine, sp = 0u;
    for (;;) {
        sum = 0u; cnt = 0u; mine = 0u;
#pragma unroll
        for (unsigned j = 0; j < 16; ++j) { const unsigned c = xb_ld(&bar[XB_XCNT(j)]); sum += c; cnt += (c > 0u) ? 1u : 0u; mine = (j == x) ? c : mine; }
        if (sum == G) break;
        __builtin_amdgcn_s_sleep(1);
        if ((++sp & 255u) == 0u) { if (xb_ld(&bar[XB_TMO])) break; if (sp > XB_SPIN_CAP) { atomicAdd(&bar[XB_TMO], 1u); break; } }
    }
    nloc = mine > 0u ? mine : 1u; nx = cnt > 0u ? cnt : 1u;
}

__device__ __forceinline__ void xcd_barrier(const XcdBarrier& b) {
    asm volatile("s_waitcnt vmcnt(0)" ::: "memory");
    __syncthreads();
    if (threadIdx.x == 0) {
        unsigned* bar = b.bar;
        __builtin_amdgcn_s_waitcnt(0);
        unsigned nloc = b.st[0], nx = b.st[1];
        if (nloc == 0u) { xcd_barrier_complete(bar, b.x, nloc, nx); b.st[0] = nloc; b.st[1] = nx; }
        const unsigned old = xb_add(&bar[XB_XSUB(b.x)], 1u);
        const unsigned gen = old / nloc;
        if (old + 1u == (gen + 1u) * nloc) {
            __builtin_amdgcn_fence(__ATOMIC_RELEASE, "agent");
            asm volatile("s_waitcnt vmcnt(0)" ::: "memory");
            const unsigned og = xb_add(&bar[XB_TOP], 1u);
            const unsigned tg = og / nx;
            if (og + 1u == (tg + 1u) * nx) xb_add(&bar[XB_TOPGEN], 1u);
            else XB_SPIN(xb_ld(&bar[XB_TOPGEN]) == tg, bar);
            __builtin_amdgcn_fence(__ATOMIC_ACQUIRE, "agent");
            xb_add(&bar[XB_XGEN(b.x)], 1u);
            asm volatile("s_waitcnt vmcnt(0)" ::: "memory");
        } else {
            XB_SPIN(xb_ld(&bar[XB_XGEN(b.x)]) == gen, bar);
            __builtin_amdgcn_fence(__ATOMIC_ACQUIRE, "agent");
            asm volatile("s_waitcnt vmcnt(0)" ::: "memory");
        }
    }
    __syncthreads();
}


#define R_G 1
#define R_PRO 1
#define PROBE_MASK 0
#define XSYNC 0
#define R_NA 1
#define R_DA 1
#define R_GLA1 1
#define R_LRU1 1
#define R_GLA3 1
#define R_LRU3 1
#define R_DAC 1
__global__ void __launch_bounds__(NTHR, 2) hybrid_fwd(Params P) {
    extern __shared__ __attribute__((aligned(16))) unsigned char lds_raw[];
    cg::grid_group grid = cg::this_grid();
    const int ph_lo = P.ph_lo, ph_hi = P.ph_hi;
    int again = 0;
    { volatile LAS unsigned* st0 = (volatile LAS unsigned*)((LAS unsigned char*)lds_raw + (LDS_BYTES - 256));
      if (threadIdx.x < 2) st0[threadIdx.x] = 0u;
      __syncthreads();
      (void)xcd_barrier_post((unsigned*)(P.ws + WS_CTL), st0); }
#define GSYNC() do { XcdBarrier xb_; xb_.bar = (unsigned*)(get_pp()->ws + WS_CTL); xb_.x = xb_xcc_id(); xb_.st = (volatile LAS unsigned*)((LAS unsigned char*)lds_raw + (LDS_BYTES - 256)); xcd_barrier(xb_); } while (0)
    for (int ph = ph_lo; ph < ph_hi; ++ph) {
        PP pp = get_pp(); unsigned char* ws = pp->ws;
        int tid = threadIdx.x; asm volatile("" : "+v"(tid));
        int bid = blockIdx.x; asm volatile("" : "+s"(bid));
        int G = gridDim.x; asm volatile("" : "+s"(G));
        PG8_LAS unsigned char* l3 = (PG8_LAS unsigned char*)lds_raw; asm volatile("" : "+s"(l3));
        unsigned char* lds = (unsigned char*)l3;
        const int lane = tid & 63, wave = __builtin_amdgcn_readfirstlane(tid >> 6);
        const int gw = bid * 8 + wave, ngw = G * 8;
        const int gt = bid * NTHR + tid, ngt = G * NTHR;
        if (ph == 0) { for (int rep = 0; rep < R_PRO; ++rep) prologue(tid, lane, wave, bid, G, lds); }
        else {
            const int l = (ph - 1) / 9, t = (ph - 1) % 9;
            const bool fusedn = FUSE_NORM && (G == 256);
            if (fusedn && (t == 5 || t == 8)) continue;
            if (fusedn && (t == 4 || t == 7)) {
                pg8::Gemm g; pg8::EpiRms2 E;
                const int inst = l * 2 + (t == 7);
                pg8::PanelStats s1{(unsigned*)(ws + WS_XB), (unsigned*)(ws + WS_CTL + CTL_SEAM) + (size_t)(inst * 2 + 0) * 4096, (unsigned*)(ws + WS_CTL + CTL_TMO), DM / 256, EPS, 0x700u};
                pg8::PanelStats s2{(unsigned*)(ws + WS_XB + 524288), (unsigned*)(ws + WS_CTL + CTL_SEAM) + (size_t)(inst * 2 + 1) * 4096, (unsigned*)(ws + WS_CTL + CTL_TMO), DM / 256, EPS, 0x780u};
                if (t == 4) { g = pg8::Gemm{(const u16*)(ws + WS_H), (const u16*)(ws + WS_WOUT) + (size_t)l * DM * DM, MTOK, DM, DM};
                    E = pg8::EpiRms2{l == 0 ? pp->in[0] : pp->out, pp->out, (u16*)(ws + WS_H), DM, pp->in[2] + (size_t)l * DM, pp->in[16] + (size_t)l * DM, s1, s2}; }
                else { g = pg8::Gemm{(const u16*)(ws + WS_P), (const u16*)(ws + WS_WF2) + (size_t)l * DM * DFF, MTOK, DM, DFF};
                    E = pg8::EpiRms2{pp->out, pp->out, (u16*)(ws + WS_H), DM, pp->in[17] + (size_t)l * DM, pp->in[1] + (size_t)(l + 1 < DEPTH ? l + 1 : l) * DM, s1, s2}; }
                pg8::StaticOrder S; S.init(g.M, g.N, G, bid);
                pg8::gemm_phase<pg8::EpiRms2, pg8::StaticOrder, false, true>(l3, g, S, E, tid);
            } else
#ifndef SKIP_G1
            if (t == 0 || t == 4 || t == 7) {
                pg8::Gemm g; pg8::EpiStore E;
                if (t == 0) { g = pg8::Gemm{(const u16*)(ws + WS_H), (const u16*)(ws + WS_WIN) + (size_t)l * DIN_PAD * DM, MTOK, ZSPLIT ? 3072 : DIN_PAD, DM}; E = ZSPLIT ? pg8::EpiStore{(u16*)(ws + WS_P), DIN, 3072, 1024, 32} : pg8::EpiStore{(u16*)(ws + WS_P), DIN, DIN, 1 << 30, 0}; }
                else if (t == 4) { g = pg8::Gemm{(const u16*)(ws + WS_H), (const u16*)(ws + WS_WOUT) + (size_t)l * DM * DM, MTOK, DM, DM}; E = pg8::EpiStore{(u16*)(ws + WS_P), DM, DM, 1 << 30, 0}; }
                else { g = pg8::Gemm{(const u16*)(ws + WS_P), (const u16*)(ws + WS_WF2) + (size_t)l * DM * DFF, MTOK, DM, DFF}; E = pg8::EpiStore{(u16*)(ws + WS_GLA), DM, DM, 1 << 30, 0}; }
                pg8::StaticOrder S; S.init(g.M, g.N, G, bid);
                for (int rep = 0; rep < R_G; ++rep) pg8::gemm_phase<pg8::EpiStore, pg8::StaticOrder, true, true>(l3, g, S, E, tid);
                if (ZSPLIT && t == 0) {
                    const int w = __builtin_amdgcn_readfirstlane(tid >> 6), fr = lane & 15, fq = lane >> 4, mt = w & 3, kh = w >> 2;
                    float* red = (float*)lds;
                    for (int rb = bid; rb < MTOK / 64; rb += G) {
                        const u16* A = (const u16*)(ws + WS_H) + (size_t)(rb * 64 + 16 * mt + fr) * DM + kh * 512 + 8 * fq;
                        const u16* B0 = (const u16*)(ws + WS_WIN) + ((size_t)l * DIN_PAD + 3072 + fr) * DM + kh * 512 + 8 * fq; const u16* B1 = B0 + 16 * DM;
                        f32x4 z0 = (f32x4){0.f, 0.f, 0.f, 0.f}, z1 = z0;
#pragma unroll
                        for (int hb = 0; hb < 2; ++hb) {
                            bf16x8 av[8], b0v[8], b1v[8];
#pragma unroll
                            for (int s = 0; s < 8; ++s) { av[s] = ldfrag(A + 32 * (8 * hb + s)); b0v[s] = ldfrag(B0 + 32 * (8 * hb + s)); b1v[s] = ldfrag(B1 + 32 * (8 * hb + s)); }
                            __builtin_amdgcn_sched_barrier(0);
#pragma unroll
                            for (int s = 0; s < 8; ++s) { z0 = mfma16(av[s], b0v[s], z0); z1 = mfma16(av[s], b1v[s], z1); }
                        }
                        __syncthreads();
                        if (kh == 1) {
#pragma unroll
                            for (int j = 0; j < 4; ++j) { red[(16 * mt + 4 * fq + j) * 33 + fr] = z0[j]; red[(16 * mt + 4 * fq + j) * 33 + 16 + fr] = z1[j]; } }
                        __syncthreads();
                        if (kh == 0) { u16* pz = (u16*)(ws + WS_P) + (size_t)(rb * 64 + 16 * mt + 4 * fq) * DIN + C_ZA;
#pragma unroll
                            for (int j = 0; j < 4; ++j) { pz[(size_t)j * DIN + fr] = (u16)f2bf(z0[j] + red[(16 * mt + 4 * fq + j) * 33 + fr]); pz[(size_t)j * DIN + 16 + fr] = (u16)f2bf(z1[j] + red[(16 * mt + 4 * fq + j) * 33 + 16 + fr]); } }
                    }
                }
            } else
#endif
#ifndef SKIP_G3
            if (t == 6) {
                pg8::Gemm g{(const u16*)(ws + WS_H), (const u16*)(ws + WS_WF1) + (size_t)l * 2 * DFF * DM, MTOK, 2 * DFF, DM};
                pg8::EpiSwiGLU E{(u16*)(ws + WS_P), DFF};
                pg8::StaticOrder S; S.init(g.M, g.N, G, bid);
                for (int rep = 0; rep < R_G; ++rep) pg8::gemm_phase<pg8::EpiSwiGLU, pg8::StaticOrder, true, true>(l3, g, S, E, tid);
            } else
#endif
#ifndef SKIP_M1
            if (t == 1) {
                const int half = tid >> 8, ht = tid & 255; unsigned char* hl = lds + half * ATT_HALF_BYTES;
                for (int rep = 0; rep < R_NA; ++rep) for (int pi = bid; pi < 256; pi += G) attn_unit<0>(l, 2 * pi + half, hl, ht);
                for (int rep = 0; rep < R_DA; ++rep) for (int pi = bid; pi < 768; pi += G) attn_unit<1>(l, 2 * pi + half, hl, ht);
                for (int rep = 0; rep < R_GLA1; ++rep) gla1_phase(l, lds, tid, bid, G);
                for (int rep = 0; rep < R_LRU1; ++rep) lru_phase<1>(l, lds, tid, bid, G);
            } else
#endif
            if (t == 2) {
                gla2_scan(tid, bid, G);
                lru2_scan(tid, bid, G);
            } else
#ifndef SKIP_M3
            if (t == 3) {
                for (int rep = 0; rep < R_GLA3; ++rep) gla3_phase(l, lds, tid, bid, G);
                for (int rep = 0; rep < R_LRU3; ++rep) lru_phase<3>(l, lds, tid, bid, G);
                for (int rep = 0; rep < R_DAC; ++rep) da_combine(gt, ngt);
            } else
#endif
            if (t == 5) {
                row_pass(1, l == 0 ? pp->in[0] : pp->out, pp->out, (const u16*)(ws + WS_P), pp->in[2] + (size_t)l * DM, pp->in[16] + (size_t)l * DM, (u16*)(ws + WS_H), gw, ngw, lane);
            } else if (t == 8) {
                row_pass(1, pp->out, pp->out, (const u16*)(ws + WS_GLA), pp->in[17] + (size_t)l * DM, (l + 1 < DEPTH) ? pp->in[1] + (size_t)(l + 1) * DM : nullptr, (u16*)(ws + WS_H), gw, ngw, lane);
            }
        }
        if (PROBE_MASK && ph > 0 && ((PROBE_MASK >> ((ph - 1) % 9)) & 1) && !again) { again = 1; --ph; GSYNC(); continue; }
        again = 0;
        for (int xs = 0; xs < XSYNC; ++xs) GSYNC();
        if (ph + 1 < ph_hi) { if (ph_hi > 4096) grid.sync();
            GSYNC(); }
    }
}

#ifndef N_LAUNCH_MODE
#define N_LAUNCH_MODE 1
#endif
constexpr int N_PHASES = 1 + 9 * DEPTH;
extern "C" void kernel_launch(void* const* d_in, const int* in_sizes, int n_in, void* d_out, int out_size, void* d_ws, size_t ws_size, hipStream_t stream) {
    static int grid = 0;
    if (grid == 0) {
        if (n_in != 20 || ws_size < WS_END) { fprintf(stderr, "kernel_launch: need 20 inputs and %zu B workspace (got %d, %zu)\n", (size_t)WS_END, n_in, ws_size); grid = -1; return; }
        int dev = 0, cus = 0, per_cu = 0;
        hipGetDevice(&dev); hipDeviceGetAttribute(&cus, hipDeviceAttributeMultiprocessorCount, dev);
        if (hipFuncSetAttribute((const void*)hybrid_fwd, hipFuncAttributeMaxDynamicSharedMemorySize, LDS_BYTES) != hipSuccess) { fprintf(stderr, "hipFuncSetAttribute failed\n"); grid = -1; return; }
        if (hipOccupancyMaxActiveBlocksPerMultiprocessor(&per_cu, (const void*)hybrid_fwd, NTHR, LDS_BYTES) != hipSuccess || per_cu < 1) { fprintf(stderr, "occupancy query: %d\n", per_cu); per_cu = 1; }
        (void)hipGetLastError();
        grid = cus * 1;
        if (per_cu < 1) grid = -1;
    }
    if (grid < 0) return;
    if (hipMemsetAsync((char*)d_ws + WS_CTL, 0, CTL_BYTES, stream) != hipSuccess) { fprintf(stderr, "memset failed\n"); return; }
    Params p{};
    for (int i = 0; i < 20; ++i) p.in[i] = (const float*)d_in[i];
    p.out = (float*)d_out; p.ws = (unsigned char*)d_ws;
#if N_LAUNCH_MODE == 1
    p.ph_lo = 0; p.ph_hi = N_PHASES;
    { void* args[] = {&p}; hipError_t e = hipLaunchCooperativeKernel((const void*)hybrid_fwd, dim3(grid), dim3(NTHR), args, LDS_BYTES, stream);
      if (e != hipSuccess) fprintf(stderr, "cooperative launch failed: %s\n", hipGetErrorString(e)); }
#else
    for (int ph = 0; ph < N_PHASES; ++ph) { p.ph_lo = ph; p.ph_hi = ph + 1; void* args[] = {&p};
        hipError_t e = hipLaunchCooperativeKernel((const void*)hybrid_fwd, dim3(grid), dim3(NTHR), args, LDS_BYTES, stream);
        if (e != hipSuccess) { fprintf(stderr, "launch %d failed: %s\n", ph, hipGetErrorString(e)); break; } }
#endif
}
```

```cpp
#include <hip/hip_runtime.h>
#include <hip/hip_cooperative_groups.h>
#include <cstdio>
#include <cstdint>
namespace cg = cooperative_groups;
namespace pg8 {
#define PG8_LAS __attribute__((address_space(3)))
typedef unsigned short bf16_t;
typedef short bf16x8 __attribute__((ext_vector_type(8)));
typedef float f32x4 __attribute__((ext_vector_type(4)));
typedef unsigned u32x4 __attribute__((ext_vector_type(4)));
constexpr int BM = 256, BK = 64, HALF = 128, HTB = HALF * BK * 2  , STAGE_BYTES = 8 * HTB, NXCD = 8, WGM = 8;

__host__ __device__ __forceinline__ int lds_byte(int r, int c) { const int st = (r >> 4) * 2 + (c >> 5), rr = r & 15, cc = c & 31, ob = rr * 64 + cc * 2; return st * 1024 + (ob ^ (((ob >> 9) & 1) << 5)); }
__host__ __device__ __forceinline__ void stage_rc(int b, int& R, int& C) { const int st = b / 1024, sb = b % 1024, swz = sb ^ (((sb >> 9) & 1) << 5); R = (st >> 1) * 16 + swz / 64; C = (st & 1) * 32 + (swz % 64) / 2; }
__host__ __device__ __forceinline__ int perm32(int rho) { const int n = rho >> 4, i = rho & 15; return 8 * (i >> 2) + 4 * n + (i & 3); }

struct Unit { int pm, pn; };
struct Gemm { const bf16_t* A; const bf16_t* Bt; int M, N, K; };

struct StaticOrder {
    int nM, nN, nwg, G, c;
    __host__ __device__ void init(int M, int N, int G_, int c_) { nM = M / BM; nN = N / BM; nwg = nM * nN; G = G_; c = c_; }
    __host__ __device__ bool next(int i, Unit& u) const {
        const long L = (long)i * G + c; if (L >= nwg) return false;
        int wgid = (int)L; { const int q = nwg / NXCD, r = nwg % NXCD, xcd = wgid % NXCD, off = wgid / NXCD; wgid = (xcd < r ? xcd * (q + 1) : r * (q + 1) + (xcd - r) * q) + off; }
        const int nig = WGM * nN, gid = wgid / nig, fm = gid * WGM, gsz = (nM - fm) < WGM ? (nM - fm) : WGM;
        u.pm = fm + ((wgid % nig) % gsz); u.pn = (wgid % nig) / gsz; return true;
    }
    __device__ __forceinline__ void a_ready(const Unit&) const {}
    __device__ __forceinline__ void done(const Unit&) const {}
};

__device__ __forceinline__ unsigned cvt_pk_bf16(float lo, float hi) { unsigned r; asm volatile("v_cvt_pk_bf16_f32 %0, %1, %2" : "=v"(r) : "v"(lo), "v"(hi)); return r; }
template <class Epi, class Sched, bool ALIGN_EPI = false, bool SP2 = false>
__device__ __forceinline__ void gemm_phase(PG8_LAS unsigned char* lds, const Gemm g, const Sched& S, const Epi& E, const int tid) {
    const int wid = __builtin_amdgcn_readfirstlane(tid >> 6), lane = tid & 63, wr = wid >> 2, wc = wid & 3, fr = lane & 15, fq = lane >> 4;
    const int K = g.K, nt = K / BK;
    unsigned voffA[2], voffB[2];
#pragma unroll
    for (int i = 0; i < 2; ++i) { int R, C; stage_rc(tid * 16 + i * 8192, R, C); const int Rb = Epi::PERM ? ((R & ~31) + perm32(R & 31)) : R;
        voffA[i] = (unsigned)(R * K + C) * 2u; voffB[i] = (unsigned)(Rb * K + C) * 2u; }
    const size_t kstep = (size_t)(BK * 2);
    const size_t hstep = (size_t)HALF * K * 2;
    const size_t tstep = 2 * hstep;
    const unsigned ldsw = (unsigned)wid * 1024u;
    const int aoff = lds_byte(wr * 64 + fr, fq * 8), boff = lds_byte(wc * 32 + fr, fq * 8);
#define PG8_SA(b, h) (((b) * 2 + (h)) * HTB)
#define PG8_SB(b, h) ((4 + (b) * 2 + (h)) * HTB)
#define PG8_STAGE(bufoff, gbase, voff) do { _Pragma("unroll") for (int _i = 0; _i < 2; ++_i) \
        __builtin_amdgcn_global_load_lds((const unsigned*)((const char*)(gbase) + (voff)[_i]), (PG8_LAS unsigned*)(lds + (bufoff) + ldsw + _i * 8192), 16, 0, 0); } while (0)
#define PG8_LDA(dst, b, h) do { _Pragma("unroll") for (int m = 0; m < 4; ++m) _Pragma("unroll") for (int k = 0; k < 2; ++k) dst[m][k] = *(const PG8_LAS bf16x8*)(lds + PG8_SA(b, h) + aoff + m * 2048 + k * 1024); } while (0)
#define PG8_LDB(dst, b, h) do { _Pragma("unroll") for (int n = 0; n < 2; ++n) _Pragma("unroll") for (int k = 0; k < 2; ++k) dst[n][k] = *(const PG8_LAS bf16x8*)(lds + PG8_SB(b, h) + boff + n * 2048 + k * 1024); } while (0)
#define PG8_MMA(ai, bj, At, Bt) do { __builtin_amdgcn_s_setprio(1); _Pragma("unroll") for (int m = 0; m < 4; ++m) _Pragma("unroll") for (int n = 0; n < 2; ++n) _Pragma("unroll") for (int k = 0; k < 2; ++k) \
        acc[ai][bj][m][n] = __builtin_amdgcn_mfma_f32_16x16x32_bf16(Bt[n][k], At[m][k], acc[ai][bj][m][n], 0, 0, 0); __builtin_amdgcn_s_setprio(0); } while (0)
#define PG8_WAIT_V(n) asm volatile("s_waitcnt vmcnt(" #n ")" ::: "memory")
#define PG8_WAIT_L(n) asm volatile("s_waitcnt lgkmcnt(" #n ")" ::: "memory")
#define PG8_BAR __builtin_amdgcn_s_barrier()
#define PG8_SCHED __builtin_amdgcn_sched_barrier(0)
    Unit cur, nxt; int ui = 0;
    if (!S.next(0, cur)) return;
    f32x4 acc[2][2][4][2];
#pragma unroll
    for (int a = 0; a < 2; ++a)
#pragma unroll
        for (int b = 0; b < 2; ++b)
#pragma unroll
            for (int m = 0; m < 4; ++m)
#pragma unroll
                for (int n = 0; n < 2; ++n) acc[a][b][m][n] = (f32x4){0.f, 0.f, 0.f, 0.f};
    bf16x8 At[4][2], B0[2][2], B1[2][2];
    const char* cA = (const char*)g.A + (size_t)cur.pm * tstep; const char* cB = (const char*)g.Bt + (size_t)cur.pn * tstep;
    S.a_ready(cur);
    if constexpr (SP2) {
        PG8_STAGE(PG8_SB(0, 0), cB, voffB); PG8_STAGE(PG8_SB(0, 1), cB + hstep, voffB); PG8_STAGE(PG8_SA(0, 0), cA, voffA); PG8_STAGE(PG8_SA(0, 1), cA + hstep, voffA);
        if (wr == 1) PG8_BAR;
        PG8_WAIT_V(2); PG8_BAR;
        PG8_STAGE(PG8_SB(1, 0), cB + kstep, voffB); PG8_STAGE(PG8_SA(1, 0), cA + kstep, voffA); PG8_STAGE(PG8_SB(1, 1), cB + hstep + kstep, voffB);
        PG8_WAIT_V(6); PG8_BAR;
    } else {
        PG8_STAGE(PG8_SB(0, 0), cB, voffB); PG8_STAGE(PG8_SA(0, 0), cA, voffA); PG8_STAGE(PG8_SB(0, 1), cB + hstep, voffB); PG8_STAGE(PG8_SA(0, 1), cA + hstep, voffA);
        if (wr == 1) PG8_BAR;
        PG8_WAIT_V(4); PG8_BAR;
        PG8_STAGE(PG8_SB(1, 0), cB + kstep, voffB); PG8_STAGE(PG8_SA(1, 0), cA + kstep, voffA); PG8_STAGE(PG8_SB(1, 1), cB + hstep + kstep, voffB);
        PG8_WAIT_V(6); PG8_BAR;
    }
    for (;;) {
        const bool has_next = S.next(ui + 1, nxt);
        const char* nA = has_next ? (const char*)g.A + (size_t)nxt.pm * tstep : cA; const char* nB = has_next ? (const char*)g.Bt + (size_t)nxt.pn * tstep : cB;
        for (int t = 0; t < nt; t += 2) {
            const bool last = (t == nt - 2);
            const char* a1 = cA + (size_t)(t + 1) * kstep;
            const char* a2 = last ? nA : cA + (size_t)(t + 2) * kstep; const char* b2 = last ? nB : cB + (size_t)(t + 2) * kstep;
            const char* a3 = a2 + kstep; const char* b3 = b2 + kstep;
            if (last && has_next) S.a_ready(nxt);
            if constexpr (SP2) {
            PG8_LDB(B0, 0, 0); PG8_LDB(B1, 0, 1); PG8_SCHED; PG8_LDA(At, 0, 0); PG8_STAGE(PG8_SA(1, 1), a1 + hstep, voffA);
            PG8_WAIT_V(8); PG8_WAIT_L(0); PG8_BAR; PG8_MMA(0, 0, At, B0); PG8_MMA(0, 1, At, B1); PG8_BAR; PG8_SCHED;
            PG8_LDA(At, 0, 1); PG8_STAGE(PG8_SB(0, 0), b2, voffB); PG8_STAGE(PG8_SB(0, 1), b2 + hstep, voffB); PG8_STAGE(PG8_SA(0, 0), a2, voffA);
            PG8_WAIT_V(8); PG8_WAIT_L(0); PG8_BAR; PG8_MMA(1, 0, At, B0); PG8_MMA(1, 1, At, B1); PG8_BAR; PG8_SCHED;
            PG8_LDB(B0, 1, 0); PG8_LDB(B1, 1, 1); PG8_SCHED; PG8_LDA(At, 1, 0); PG8_STAGE(PG8_SA(0, 1), a2 + hstep, voffA);
            PG8_WAIT_V(8); PG8_WAIT_L(0); PG8_BAR; PG8_MMA(0, 0, At, B0); PG8_MMA(0, 1, At, B1); PG8_BAR; PG8_SCHED;
            PG8_LDA(At, 1, 1); PG8_STAGE(PG8_SB(1, 0), b3, voffB); PG8_STAGE(PG8_SB(1, 1), b3 + hstep, voffB); PG8_STAGE(PG8_SA(1, 0), a3, voffA);
            PG8_WAIT_V(8); PG8_WAIT_L(0); PG8_BAR; PG8_MMA(1, 0, At, B0); PG8_MMA(1, 1, At, B1); PG8_BAR; PG8_SCHED;
            } else {
            PG8_LDB(B0, 0, 0); PG8_SCHED; PG8_LDA(At, 0, 0); PG8_STAGE(PG8_SA(1, 1), a1 + hstep, voffA);
            PG8_WAIT_L(8); PG8_BAR; PG8_WAIT_L(0); PG8_MMA(0, 0, At, B0); PG8_BAR; PG8_SCHED;
            PG8_LDB(B1, 0, 1); PG8_STAGE(PG8_SB(0, 0), b2, voffB);
            PG8_BAR; PG8_WAIT_L(0); PG8_MMA(0, 1, At, B1); PG8_BAR;
            PG8_LDA(At, 0, 1); PG8_STAGE(PG8_SA(0, 0), a2, voffA);
            PG8_BAR; PG8_WAIT_L(0); PG8_MMA(1, 0, At, B0); PG8_BAR; PG8_SCHED;
            PG8_STAGE(PG8_SB(0, 1), b2 + hstep, voffB);
            PG8_WAIT_V(6); PG8_BAR; PG8_MMA(1, 1, At, B1); PG8_BAR;
            PG8_LDB(B0, 1, 0); PG8_SCHED; PG8_LDA(At, 1, 0); PG8_STAGE(PG8_SA(0, 1), a2 + hstep, voffA);
            PG8_WAIT_L(8); PG8_BAR; PG8_WAIT_L(0); PG8_MMA(0, 0, At, B0); PG8_BAR; PG8_SCHED;
            PG8_LDB(B1, 1, 1); PG8_STAGE(PG8_SB(1, 0), b3, voffB);
            PG8_BAR; PG8_WAIT_L(0); PG8_MMA(0, 1, At, B1); PG8_BAR;
            PG8_LDA(At, 1, 1); PG8_STAGE(PG8_SA(1, 0), a3, voffA);
            PG8_BAR; PG8_WAIT_L(0); PG8_MMA(1, 0, At, B0); PG8_BAR; PG8_SCHED;
            PG8_STAGE(PG8_SB(1, 1), b3 + hstep, voffB);
            PG8_WAIT_V(6); PG8_BAR; PG8_MMA(1, 1, At, B1); PG8_BAR;
            }
        }
        if constexpr (ALIGN_EPI) { if (wr == 0) PG8_BAR; }
        if constexpr (!Epi::AFTER_DRAIN) { E(acc, cur, wr, wc, fr, fq); S.done(cur); }
        if (!has_next) break;
#pragma unroll
        for (int a = 0; a < 2; ++a)
#pragma unroll
            for (int b = 0; b < 2; ++b)
#pragma unroll
                for (int m = 0; m < 4; ++m)
#pragma unroll
                    for (int n = 0; n < 2; ++n) acc[a][b][m][n] = (f32x4){0.f, 0.f, 0.f, 0.f};
        cur = nxt; cA = nA; cB = nB; ++ui;
        if constexpr (ALIGN_EPI) { if (wr == 1) PG8_BAR; }
    }
    PG8_WAIT_V(0);
    if constexpr (!ALIGN_EPI) { if (wr == 0) PG8_BAR; }
    PG8_BAR;
    if constexpr (Epi::AFTER_DRAIN) { E.fused(acc, cur, wr, wc, fr, fq, lds, wid, lane); S.done(cur); }
#undef PG8_SA
#undef PG8_SB
#undef PG8_STAGE
#undef PG8_LDA
#undef PG8_LDB
#undef PG8_MMA
#undef PG8_WAIT_V
#undef PG8_WAIT_L
#undef PG8_BAR
#undef PG8_SCHED
}
}

namespace pg8 {
struct EpiStore {
    static constexpr bool PERM = true, AFTER_DRAIN = false;
    bf16_t* O; int ldc; int ncols; int shift_from, shift;
    __device__ __forceinline__ void operator()(const f32x4 (&acc)[2][2][4][2], const Unit& u, int wr, int wc, int fr, int fq) const {
        const int row0 = u.pm * BM + wr * 64 + fr; const int col0 = u.pn * BM + wc * 32 + 8 * fq;
#pragma unroll
        for (int ai = 0; ai < 2; ++ai)
#pragma unroll
            for (int m = 0; m < 4; ++m) { bf16_t* rowp = O + (size_t)(row0 + ai * HALF + m * 16) * ldc;
#pragma unroll
                for (int bj = 0; bj < 2; ++bj) { const int col = col0 + bj * HALF;
                    if (col < ncols) { const f32x4 v0 = acc[ai][bj][m][0], v1 = acc[ai][bj][m][1];
                        u32x4 w; w.x = cvt_pk_bf16(v0[0], v0[1]); w.y = cvt_pk_bf16(v0[2], v0[3]); w.z = cvt_pk_bf16(v1[0], v1[1]); w.w = cvt_pk_bf16(v1[2], v1[3]);
                        *(u32x4*)(rowp + col + (col >= shift_from ? shift : 0)) = w; } } }
    }
};
struct EpiSwiGLU {
    static constexpr bool PERM = true, AFTER_DRAIN = false;
    bf16_t* O; int ldc;
    __device__ __forceinline__ void operator()(const f32x4 (&acc)[2][2][4][2], const Unit& u, int wr, int wc, int fr, int fq) const {
        const int row0 = u.pm * BM + wr * 64 + fr; const int col0 = u.pn * BM + wc * 32 + 8 * fq;
#pragma unroll
        for (int ai = 0; ai < 2; ++ai)
#pragma unroll
            for (int m = 0; m < 4; ++m) { bf16_t* rowp = O + (size_t)(row0 + ai * HALF + m * 16) * ldc;
#pragma unroll
                for (int bj = 0; bj < 2; ++bj) { const int col = col0 + bj * HALF; const f32x4 g = acc[ai][bj][m][0], up = acc[ai][bj][m][1];
                    float r[4];
#pragma unroll
                    for (int i = 0; i < 4; ++i) r[i] = g[i] * __builtin_amdgcn_rcpf(1.f + __expf(-g[i])) * up[i];
                    uint2 w; w.x = cvt_pk_bf16(r[0], r[1]); w.y = cvt_pk_bf16(r[2], r[3]);
                    *(uint2*)(rowp + (col >> 1)) = w; } }
    }
};

struct PanelStats {
    unsigned* xbuf;
    unsigned* cnt;
    unsigned* tmo;
    int ntn; float eps;
    unsigned code;
    __device__ __forceinline__ bool run(const f32x4 (&v)[2][2][4][2], const Unit& u, int wr, int wc, int fr, int fq, PG8_LAS unsigned char* lds, int wid, int lane) const {
        typedef float f32x2v __attribute__((ext_vector_type(2)));
        PG8_LAS f32x2v* P = (PG8_LAS f32x2v*)lds;
        PG8_LAS f32x2v* S = (PG8_LAS f32x2v*)(lds + 8192);
        PG8_LAS unsigned* flag = (PG8_LAS unsigned*)(lds + 8192 + 2048);
#pragma unroll
        for (int ai = 0; ai < 2; ++ai)
#pragma unroll
            for (int m = 0; m < 4; ++m) {
                float s = 0.f;
#pragma unroll
                for (int bj = 0; bj < 2; ++bj)
#pragma unroll
                    for (int n = 0; n < 2; ++n) { const f32x4 x = v[ai][bj][m][n]; s += (x[0] + x[1]) + (x[2] + x[3]); }
                s += __shfl_xor(s, 16); s += __shfl_xor(s, 32);
                const float mw = s * (1.0f / 64.0f); float q = 0.f;
#pragma unroll
                for (int bj = 0; bj < 2; ++bj)
#pragma unroll
                    for (int n = 0; n < 2; ++n) { const f32x4 d = v[ai][bj][m][n] - mw; q += (d[0] * d[0] + d[1] * d[1]) + (d[2] * d[2] + d[3] * d[3]); }
                q += __shfl_xor(q, 16); q += __shfl_xor(q, 32);
                if (fq == 0) P[(ai * HALF + wr * 64 + m * 16 + fr) * 4 + wc] = (f32x2v){mw, q};
            }
        asm volatile("s_waitcnt lgkmcnt(0)" ::: "memory"); __builtin_amdgcn_s_barrier(); asm volatile("" ::: "memory");
        const int row = wid * 32 + (lane & 31);
        if (lane < 32) {
            const f32x2v a = P[row * 4 + 0], b = P[row * 4 + 1], c = P[row * 4 + 2], d = P[row * 4 + 3];
            const float mt = (a.x + b.x + c.x + d.x) * 0.25f;
            const float da = a.x - mt, db = b.x - mt, dc = c.x - mt, dd = d.x - mt;
            const float m2 = (a.y + b.y) + (c.y + d.y) + 64.0f * ((da * da + db * db) + (dc * dc + dd * dd));
            unsigned long long* slot = (unsigned long long*)xbuf + ((size_t)(u.pm * BM + row) * 4 + u.pn);
            __hip_atomic_store(slot, ((unsigned long long)__float_as_uint(m2) << 32) | __float_as_uint(mt), __ATOMIC_RELAXED, __HIP_MEMORY_SCOPE_AGENT);
        }
        asm volatile("s_waitcnt vmcnt(0)" ::: "memory");
        if (lane == 0) __hip_atomic_fetch_add(cnt + 64 * u.pm, 1u, __ATOMIC_RELAXED, __HIP_MEMORY_SCOPE_AGENT);
        if (wid == 0) {
            bool dead = false; const unsigned long long t0 = __builtin_amdgcn_s_memrealtime(); const unsigned want = 8u * (unsigned)ntn;
            for (;;) {
                if ((unsigned)__builtin_amdgcn_readfirstlane(__hip_atomic_load(cnt + 64 * u.pm, __ATOMIC_RELAXED, __HIP_MEMORY_SCOPE_AGENT)) >= want) break;
                if (__builtin_amdgcn_s_memrealtime() - t0 > 2000000ull) {
                    if (lane == 0) { unsigned expect = 0u; __hip_atomic_compare_exchange_strong(tmo + 1, &expect, code | (unsigned)(u.pm & 0xff), __ATOMIC_RELAXED, __ATOMIC_RELAXED, __HIP_MEMORY_SCOPE_AGENT);
                                     __hip_atomic_store(tmo, 1u, __ATOMIC_RELAXED, __HIP_MEMORY_SCOPE_AGENT); }
                    dead = true; break; }
                __builtin_amdgcn_s_sleep(2);
            }
            __builtin_amdgcn_fence(__ATOMIC_ACQUIRE, "agent");
            if (lane == 0) flag[0] = dead ? 1u : 0u;
        }
        asm volatile("s_waitcnt vmcnt(0) lgkmcnt(0)" ::: "memory"); __builtin_amdgcn_s_barrier(); asm volatile("" ::: "memory");
        const bool bad = flag[0] != 0u;
        if (lane < 32) {
            const unsigned long long* slot = (const unsigned long long*)xbuf + (size_t)(u.pm * BM + row) * 4; float mt[4], m2[4]; float ms = 0.f;
#pragma unroll
            for (int t = 0; t < 4; ++t) { if (t < ntn) { const unsigned long long w = __hip_atomic_load(slot + t, __ATOMIC_RELAXED, __HIP_MEMORY_SCOPE_AGENT); mt[t] = __uint_as_float((unsigned)w); m2[t] = __uint_as_float((unsigned)(w >> 32)); } else { mt[t] = 0.f; m2[t] = 0.f; } ms += mt[t]; }
            const float mean = ms / (float)ntn; float q = 0.f;
#pragma unroll
            for (int t = 0; t < 4; ++t) if (t < ntn) { const float dm = mt[t] - mean; q += m2[t] + 256.0f * dm * dm; }
            S[row] = (f32x2v){mean, 1.0f / sqrtf(q / (256.0f * (float)ntn) + mean * mean + eps)};
        }
        asm volatile("s_waitcnt lgkmcnt(0)" ::: "memory"); __builtin_amdgcn_s_barrier(); asm volatile("" ::: "memory");
        return bad;
    }
};

struct EpiRms2 {
    static constexpr bool PERM = true, AFTER_DRAIN = true;
    const float* base; float* out; bf16_t* xn; int ldc; const float* g1; const float* g2; PanelStats st1, st2;
    __device__ __forceinline__ void fused(f32x4 (&acc)[2][2][4][2], const Unit& u, int wr, int wc, int fr, int fq, PG8_LAS unsigned char* lds, int wid, int lane) const {
        typedef float f32x2v __attribute__((ext_vector_type(2)));
        const PG8_LAS f32x2v* S = (const PG8_LAS f32x2v*)(lds + 8192);
        const int col0 = u.pn * BM + wc * 32 + 8 * fq;
        bool bad = st1.run(acc, u, wr, wc, fr, fq, lds, wid, lane);
        const float qnan = __builtin_nanf("");
#pragma unroll
        for (int ai = 0; ai < 2; ++ai)
#pragma unroll
            for (int m = 0; m < 4; ++m) { const int r = ai * HALF + wr * 64 + m * 16 + fr; const f32x2v sr = S[r]; const size_t off = (size_t)(u.pm * BM + r) * ldc + col0;
#pragma unroll
                for (int bj = 0; bj < 2; ++bj)
#pragma unroll
                    for (int n = 0; n < 2; ++n) { const f32x4 bs = *(const f32x4*)(base + off + bj * HALF + n * 4); const f32x4 gv = *(const f32x4*)(g1 + col0 + bj * HALF + n * 4);
                        acc[ai][bj][m][n] = bs + acc[ai][bj][m][n] * sr.y * gv; }
                asm volatile("" : "+v"(acc[ai][0][m][0]), "+v"(acc[ai][0][m][1]), "+v"(acc[ai][1][m][0]), "+v"(acc[ai][1][m][1]));
                if (m & 1) asm volatile("" ::: "memory"); }
        const bool bad1 = bad;
        bad = st2.run(acc, u, wr, wc, fr, fq, lds, wid, lane) || bad;
#pragma unroll
        for (int ai = 0; ai < 2; ++ai)
#pragma unroll
            for (int m = 0; m < 4; ++m) { const int r = ai * HALF + wr * 64 + m * 16 + fr; const f32x2v sr = S[r]; const size_t off = (size_t)(u.pm * BM + r) * ldc + col0;
#pragma unroll
                for (int bj = 0; bj < 2; ++bj) { u32x4 w;
#pragma unroll
                    for (int n = 0; n < 2; ++n) { const f32x4 x1 = acc[ai][bj][m][n]; *(f32x4*)(out + off + bj * HALF + n * 4) = bad1 ? (f32x4){qnan, qnan, qnan, qnan} : x1;
                        const f32x4 gv = *(const f32x4*)(g2 + col0 + bj * HALF + n * 4);
                        const f32x4 o = x1 * sr.y * gv; if (n == 0) { w.x = cvt_pk_bf16(o[0], o[1]); w.y = cvt_pk_bf16(o[2], o[3]); } else { w.z = cvt_pk_bf16(o[0], o[1]); w.w = cvt_pk_bf16(o[2], o[3]); } }
                    if (bad) { w.x = 0x7fc07fc0u; w.y = 0x7fc07fc0u; w.z = 0x7fc07fc0u; w.w = 0x7fc07fc0u; }
                    *(u32x4*)(xn + off + bj * HALF) = w; }
                asm volatile("" ::: "memory"); }
    }
};
}

constexpr int L_SEQ = 8192, NB = 2, MTOK = NB * L_SEQ, DM = 1024, DIN = 3104, DIN_PAD = 3328, DFF = 2816, DEPTH = 4;
constexpr int C_QA = 0, C_KA = 256, C_VA = 512, C_GA = 768, C_ZA = 1024, C_QB = 1056, C_XC = 1824, C_GC = 2080, C_QD = 2336;
constexpr float EPS = 1e-6f;
#define FUSE_NORM 0
#define ZSPLIT 1
constexpr size_t A256(size_t x) { return (x + 255) & ~(size_t)255; }
constexpr size_t WS_CTL = 0, CTL_SEAM = 65536, CTL_TMO = 32768, CTL_BYTES = 65536 + 16 * 16384;
constexpr size_t WS_ROPE = CTL_BYTES;
constexpr size_t WS_LRUW = WS_ROPE + A256((size_t)L_SEQ * 32 * 8);
constexpr size_t WS_WIN  = WS_LRUW + A256((size_t)DEPTH * 2 * 2 * 4 * 4096 * 2);
constexpr size_t WS_WOUT = WS_WIN + (size_t)DEPTH * DIN_PAD * DM * 2;
constexpr size_t WS_WF1  = WS_WOUT + (size_t)DEPTH * DM * DM * 2;
constexpr size_t WS_WF2  = WS_WF1 + (size_t)DEPTH * 2 * DFF * DM * 2;
constexpr size_t WS_H    = WS_WF2 + (size_t)DEPTH * DM * DFF * 2;
constexpr size_t WS_P    = WS_H + (size_t)MTOK * DM * 2;
constexpr size_t WS_GLA  = WS_P + (size_t)MTOK * DIN * 2;
constexpr size_t WS_GDEC = WS_GLA + (size_t)2048 * 4096 * 4;
constexpr size_t WS_LRUA = WS_GDEC + (size_t)2048 * 64 * 4;
constexpr size_t WS_LRUH = WS_LRUA + (size_t)2 * 2 * 128 * 256 * 4;
constexpr size_t WS_DAP  = WS_LRUH + (size_t)2 * 2 * 128 * 256 * 4;
constexpr size_t WS_DAL  = WS_DAP + (size_t)3 * MTOK * 256 * 2;
constexpr size_t WS_GB   = WS_DAL + (size_t)3 * MTOK * 4 * 4;
constexpr size_t WS_XB   = WS_GB + (size_t)2048 * 4096 * 4;
constexpr size_t WS_END  = WS_XB + 2 * 524288;

constexpr int LDS_BYTES = 147456;
constexpr int NTHR = 512;

typedef unsigned short u16;
typedef short bf16x8 __attribute__((ext_vector_type(8)));
typedef float f32x4 __attribute__((ext_vector_type(4)));
typedef unsigned u32x4 __attribute__((ext_vector_type(4)));

struct Params { const float* in[20]; float* out; unsigned char* ws; int ph_lo, ph_hi; };
typedef const Params __attribute__((address_space(4)))* PP;
__device__ __forceinline__ PP get_pp() { PP p = (PP)__builtin_amdgcn_kernarg_segment_ptr(); asm volatile("" : "+s"(p)); return p; }

__device__ __forceinline__ unsigned f2bf(float f) { unsigned u = __float_as_uint(f); return (u + 0x7fffu + ((u >> 16) & 1u)) >> 16; }
__device__ __forceinline__ float bf2f(unsigned h) { return __uint_as_float(h << 16); }
__device__ __forceinline__ unsigned pk2(float lo, float hi) { return f2bf(lo) | (f2bf(hi) << 16); }
__device__ __forceinline__ float blo(unsigned w) { return __uint_as_float(w << 16); }
__device__ __forceinline__ float bhi(unsigned w) { return __uint_as_float(w & 0xffff0000u); }
#define UNPACK8(v, f) do { f[0] = blo(v.x); f[1] = bhi(v.x); f[2] = blo(v.y); f[3] = bhi(v.y); f[4] = blo(v.z); f[5] = bhi(v.z); f[6] = blo(v.w); f[7] = bhi(v.w); } while (0)
__device__ __forceinline__ unsigned cvtpk(float lo, float hi) { unsigned r; asm("v_cvt_pk_bf16_f32 %0, %1, %2" : "=v"(r) : "v"(lo), "v"(hi)); return r; }
#define PACK8(v, f) do { v.x = cvtpk(f[0], f[1]); v.y = cvtpk(f[2], f[3]); v.z = cvtpk(f[4], f[5]); v.w = cvtpk(f[6], f[7]); } while (0)
__device__ __forceinline__ f32x4 mfma16(bf16x8 a, bf16x8 b, f32x4 c) { return __builtin_amdgcn_mfma_f32_16x16x32_bf16(a, b, c, 0, 0, 0); }
__device__ __forceinline__ bf16x8 ldfrag(const u16* p) { return *(const bf16x8*)p; }
__device__ __forceinline__ float wave_sum(float v) {
#pragma unroll
    for (int o = 1; o < 64; o <<= 1) v += __shfl_xor(v, o);
    return v;
}
__device__ __forceinline__ float rcpf_(float x) { return __builtin_amdgcn_rcpf(x); }
__device__ __forceinline__ float sigmoidf_(float x) { return rcpf_(1.f + __expf(-x)); }
__device__ __forceinline__ float softplusf_(float x) { return fmaxf(x, 0.f) + __logf(1.f + __expf(-fabsf(x))); }
__device__ __forceinline__ float logsigmoidf_(float x) { return -softplusf_(-x); }
__device__ __forceinline__ float gelu_tanh(float x) { const float u = 0.7978845608028654f * (x + 0.044715f * x * x * x); return x * sigmoidf_(2.f * u); }

constexpr int LP = 72;
constexpr int FP = 65;

template <int MODE>
__device__ __forceinline__ void conv_weight(const float* __restrict__ W, int K, int N, int Npad, u16* __restrict__ WT, float* scr, int it, int lane) {
    const int nblk = Npad / 64;
    const int kr = lane >> 4, nc = lane & 15;
    {
        const int nb = it % nblk, kb = it / nblk;
        int col;
        if (MODE == 0) { col = nb * 64 + 4 * nc; if (col >= N) col = -1; }
        else if (MODE == 1) col = (nc < 8) ? nb * 32 + 4 * nc : DFF + nb * 32 + 4 * (nc - 8);
        else { const int r = nb * 64 + 4 * nc; col = (r < 1024) ? r : (r < 3072 ? r + 32 : (r < 3104 ? r - 2048 : -1)); }
        f32x4 v[16];
#pragma unroll
        for (int i = 0; i < 16; ++i) v[i] = (col >= 0) ? __builtin_nontemporal_load((const f32x4*)(W + (size_t)(kb * 64 + 4 * i + kr) * N + col)) : (f32x4){0.f, 0.f, 0.f, 0.f};
#pragma unroll
        for (int i = 0; i < 16; ++i) { float* s = scr + (4 * i + kr) * 65 + 4 * nc; s[0] = v[i].x; s[1] = v[i].y; s[2] = v[i].z; s[3] = v[i].w; }
        asm volatile("s_waitcnt lgkmcnt(0)" ::: "memory");
        int sc = lane;
        if (MODE == 1) { const int blk = lane >> 3, w = lane & 7; sc = (w < 4) ? blk * 4 + w : 32 + blk * 4 + (w - 4); }
        u16* dst = WT + (size_t)(nb * 64 + lane) * K + kb * 64;
#pragma unroll
        for (int kc = 0; kc < 8; ++kc) { float f[8];
#pragma unroll
            for (int j2 = 0; j2 < 8; ++j2) f[j2] = scr[(kc * 8 + j2) * 65 + sc];
            u32x4 o; PACK8(o, f); *(u32x4*)(dst + kc * 8) = o; }
        asm volatile("s_waitcnt lgkmcnt(0)" ::: "memory");
    }
}

__device__ __forceinline__ void row_pass(int mode, const float* xin, float* xout, const u16* yo, const float* g_post, const float* g_next, u16* hout, int gw, int ngw, int lane) {
    for (int row0 = gw; row0 < MTOK; row0 += 2 * ngw) {
        const int rows[2] = {row0, row0 + ngw}; const bool has1 = (row0 + ngw) < MTOK;
        f32x4 xv[2][4]; uint2 yw[2][4];
#pragma unroll
        for (int q = 0; q < 2; ++q) { const int row = (q == 0 || has1) ? rows[q] : row0;
#pragma unroll
            for (int j = 0; j < 4; ++j) { xv[q][j] = __builtin_nontemporal_load((const f32x4*)(xin + (size_t)row * DM + 4 * lane + 256 * j));
                if (mode == 1) { const unsigned long long t_ = __builtin_nontemporal_load((const unsigned long long*)(yo + (size_t)row * DM + 4 * lane + 256 * j)); yw[q][j] = make_uint2((unsigned)t_, (unsigned)(t_ >> 32)); } } }
        if (mode == 1) {
            float ss[2] = {0.f, 0.f}; f32x4 yv[2][4];
#pragma unroll
            for (int q = 0; q < 2; ++q)
#pragma unroll
                for (int j = 0; j < 4; ++j) { yv[q][j] = (f32x4){blo(yw[q][j].x), bhi(yw[q][j].x), blo(yw[q][j].y), bhi(yw[q][j].y)};
                    ss[q] += yv[q][j].x * yv[q][j].x + yv[q][j].y * yv[q][j].y + yv[q][j].z * yv[q][j].z + yv[q][j].w * yv[q][j].w; }
#pragma unroll
            for (int o = 1; o < 64; o <<= 1) { ss[0] += __shfl_xor(ss[0], o); ss[1] += __shfl_xor(ss[1], o); }
#pragma unroll
            for (int j = 0; j < 4; ++j) { const f32x4 g = *(const f32x4*)(g_post + 4 * lane + 256 * j);
#pragma unroll
                for (int q = 0; q < 2; ++q) { const float rs = rsqrtf(ss[q] * (1.f / DM) + EPS); xv[q][j] = xv[q][j] + yv[q][j] * rs * g;
                    if (q == 0 || has1) __builtin_nontemporal_store(xv[q][j], (f32x4*)(xout + (size_t)rows[q] * DM + 4 * lane + 256 * j)); } }
        }
        if (g_next) {
            float ss[2] = {0.f, 0.f};
#pragma unroll
            for (int q = 0; q < 2; ++q)
#pragma unroll
                for (int j = 0; j < 4; ++j) ss[q] += xv[q][j].x * xv[q][j].x + xv[q][j].y * xv[q][j].y + xv[q][j].z * xv[q][j].z + xv[q][j].w * xv[q][j].w;
#pragma unroll
            for (int o = 1; o < 64; o <<= 1) { ss[0] += __shfl_xor(ss[0], o); ss[1] += __shfl_xor(ss[1], o); }
#pragma unroll
            for (int j = 0; j < 4; ++j) { const f32x4 g = *(const f32x4*)(g_next + 4 * lane + 256 * j);
#pragma unroll
                for (int q = 0; q < 2; ++q) { const float rs = rsqrtf(ss[q] * (1.f / DM) + EPS); const f32x4 v = xv[q][j] * rs * g;
                    uint2 w; w.x = cvtpk(v.x, v.y); w.y = cvtpk(v.z, v.w);
                    if (q == 0 || has1) *(uint2*)(hout + (size_t)rows[q] * DM + 4 * lane + 256 * j) = w; } }
        }
    }
}

__device__ __forceinline__ void prologue(int tid, int lane, int wave, int bid, int G, unsigned char* lds) {
    PP pp = get_pp();
    float* scr = (float*)(lds + wave * (64 * 65 * 4));
    unsigned char* ws = pp->ws;
    const int gw = bid * 8 + wave, ngw = G * 8;
    const int gt = bid * NTHR + tid, ngt = G * NTHR;
    constexpr int I_IN = (DIN_PAD / 64) * (DM / 64), I_OUT = (DM / 64) * (DM / 64), I_F1 = (2 * DFF / 64) * (DM / 64), I_F2 = (DM / 64) * (DFF / 64);
    for (int l = 0; l < DEPTH; ++l) {
        const int o0 = (l * (I_IN + I_OUT + I_F1 + I_F2)) % ngw, o1 = (o0 + I_IN) % ngw, o2 = (o1 + I_OUT) % ngw, o3 = (o2 + I_F1) % ngw;
        for (int r = (gw + ngw - o0) % ngw; r < I_IN; r += ngw) conv_weight<ZSPLIT ? 2 : 0>(pp->in[3] + (size_t)l * DM * DIN, DM, DIN, DIN_PAD, (u16*)(ws + WS_WIN) + (size_t)l * DIN_PAD * DM, scr, r, lane);
        for (int r = (gw + ngw - o1) % ngw; r < I_OUT; r += ngw) conv_weight<0>(pp->in[15] + (size_t)l * DM * DM, DM, DM, DM, (u16*)(ws + WS_WOUT) + (size_t)l * DM * DM, scr, r, lane);
        for (int r = (gw + ngw - o2) % ngw; r < I_F1; r += ngw) conv_weight<1>(pp->in[18] + (size_t)l * DM * 2 * DFF, DM, 2 * DFF, 2 * DFF, (u16*)(ws + WS_WF1) + (size_t)l * 2 * DFF * DM, scr, r, lane);
        for (int r = (gw + ngw - o3) % ngw; r < I_F2; r += ngw) conv_weight<0>(pp->in[19] + (size_t)l * DFF * DM, DFF, DM, DM, (u16*)(ws + WS_WF2) + (size_t)l * DM * DFF, scr, r, lane);
    }
    { u16* wt = (u16*)(ws + WS_LRUW);
      for (int idx = gt; idx < DEPTH * 2 * 2 * 4 * 4096; idx += ngt) {
          const int i = idx & 63, j = (idx >> 6) & 63, h = (idx >> 12) & 3, e = (idx >> 14) & 1, mat = (idx >> 15) & 1, l = idx >> 16;
          const float* W = mat ? pp->in[12] : pp->in[10];
          wt[idx] = (u16)f2bf(W[((((size_t)l * 2 + e) * 4 + h) * 64 + i) * 64 + j]); } }
    { float2* tab = (float2*)(ws + WS_ROPE);
      for (int idx = gt; idx < L_SEQ * 32; idx += ngt) { const int pos = idx >> 5, i = idx & 31;
          const float inv = powf(10000.f, -(float)(2 * i) / 64.f); const float ang = (float)pos * inv; float s, c; sincosf(ang, &s, &c); tab[idx] = make_float2(c, s); } }
    row_pass(0, pp->in[0], nullptr, nullptr, nullptr, pp->in[1], (u16*)(ws + WS_H), gw, ngw, lane);
}

constexpr int ATT_HALF_BYTES = 6 * 64 * LP * 2 + 2048;
__device__ __forceinline__ void rope8(u32x4& lo, u32x4& hi, const float2* tab) {
    float a[8], b[8], oa[8], ob[8]; UNPACK8(lo, a); UNPACK8(hi, b);
#pragma unroll
    for (int i = 0; i < 8; ++i) { const float2 cs = tab[i]; oa[i] = a[i] * cs.x - b[i] * cs.y; ob[i] = b[i] * cs.x + a[i] * cs.y; }
    PACK8(lo, oa); PACK8(hi, ob);
}
#define VT_SCATTER(dst, v) do { (dst)[0 * LP] = (u16)((v).x & 0xffff); (dst)[1 * LP] = (u16)((v).x >> 16); (dst)[2 * LP] = (u16)((v).y & 0xffff); (dst)[3 * LP] = (u16)((v).y >> 16); \
    (dst)[4 * LP] = (u16)((v).z & 0xffff); (dst)[5 * LP] = (u16)((v).z >> 16); (dst)[6 * LP] = (u16)((v).w & 0xffff); (dst)[7 * LP] = (u16)((v).w >> 16); } while (0)
template <int TYPE>
__device__ __forceinline__ void attn_unit(int layer, int uidx, unsigned char* hl, int ht) {
    PP pp = get_pp();
    const int lane = ht & 63, hw = __builtin_amdgcn_readfirstlane(ht >> 6), fr = lane & 15, fq = lane >> 4;
    u16* Qs = (u16*)hl; u16* Ks = Qs + 2 * 64 * LP; float* Bs = (float*)(Ks + 4 * 64 * LP);
    u16* Ps = Qs;
    const u16* pbuf = (const u16*)(pp->ws + WS_P);
    const float2* rtab = (const float2*)(pp->ws + WS_ROPE);
    constexpr float LOG2E = 1.4426950408889634f;
    int b, h, r = 0, rsA = 0, rsB = 0, dil = 1, nb = 128, rho = 0, jb = 0, br = 0;
    if (TYPE == 0) { b = uidx >> 8; h = (uidx >> 6) & 3; r = 2 * (uidx & 63); rsA = min(max(r - 4, 0), 120); rsB = min(max(r - 3, 0), 120); }
    else { br = uidx >> 9; const int rem = uidx & 511; b = rem >> 8; h = (rem >> 6) & 3; const int w = rem & 63; dil = (br == 0) ? 1 : (br == 1 ? 4 : 16); nb = 128 / dil; const int nbp = nb >> 1; rho = w / nbp; jb = 2 * (w % nbp); }
    const int qstr = (TYPE == 0) ? 1 : dil;
    const int qtokA = (TYPE == 0) ? r * 64 : rho + dil * 64 * jb; const int qtokB = qtokA + 64 * qstr;
    const size_t rowbase = (size_t)b * L_SEQ;
    const int qcol = ((TYPE == 0) ? C_QB : C_QD) + h * 64;
    const int nkb = (TYPE == 0) ? 9 : 4;
    const int srow = ht >> 2, sc = ht & 3;
    const int vkp = ht >> 3, vdc = ht & 7;
#define KB_INFO(kb_, ktok0_, valid_) do { if (TYPE == 0) { const int kr_ = rsA + (kb_); valid_ = (kr_ <= rsB + 7); ktok0_ = kr_ * 64; } \
        else { const int kj_ = jb - 1 + (kb_); valid_ = (kj_ >= 0 && kj_ < nb); ktok0_ = rho + dil * 64 * kj_; } } while (0)
#define KV_PREFETCH(kt0_) do { const int tok_ = (kt0_) + qstr * srow; const u16* src_ = pbuf + (rowbase + tok_) * DIN + qcol + 256; \
        klo = *(const u32x4*)(src_ + 8 * sc); khi = *(const u32x4*)(src_ + 32 + 8 * sc); \
        if (TYPE == 1) { const f32x4* ct_ = (const f32x4*)(rtab + (size_t)tok_ * 32 + 8 * sc); pcs[0] = ct_[0]; pcs[1] = ct_[1]; pcs[2] = ct_[2]; pcs[3] = ct_[3]; } \
        const u16* vs_ = pbuf + (rowbase + (kt0_) + qstr * 2 * vkp) * DIN + qcol + 512 + 8 * vdc; va = *(const u32x4*)vs_; vb = *(const u32x4*)(vs_ + (size_t)qstr * DIN); } while (0)
    u32x4 klo, khi, va, vb; f32x4 pcs[4]; bool pvalid;
#define KV_STAGE(bufi_) do { u16* Kd_ = Ks + (bufi_) * (2 * 64 * LP); u16* Vd_ = Kd_ + 64 * LP; \
        if (TYPE == 1) { float a_[8], c_[8], oa_[8], ob_[8]; UNPACK8(klo, a_); UNPACK8(khi, c_); \
            _Pragma("unroll") for (int i_ = 0; i_ < 4; ++i_) { const f32x4 cs_ = pcs[i_]; \
                oa_[2 * i_] = a_[2 * i_] * cs_.x - c_[2 * i_] * cs_.y; ob_[2 * i_] = c_[2 * i_] * cs_.x + a_[2 * i_] * cs_.y; \
                oa_[2 * i_ + 1] = a_[2 * i_ + 1] * cs_.z - c_[2 * i_ + 1] * cs_.w; ob_[2 * i_ + 1] = c_[2 * i_ + 1] * cs_.z + a_[2 * i_ + 1] * cs_.w; } \
            PACK8(klo, oa_); PACK8(khi, ob_); } \
        *(u32x4*)(Kd_ + srow * LP + 8 * sc) = klo; *(u32x4*)(Kd_ + srow * LP + 32 + 8 * sc) = khi; \
        unsigned* vt_ = (unsigned*)(Vd_ + (8 * vdc) * LP + 2 * vkp); \
        vt_[0 * (LP / 2)] = (va.x & 0xffffu) | (vb.x << 16); vt_[1 * (LP / 2)] = (va.x >> 16) | (vb.x & 0xffff0000u); \
        vt_[2 * (LP / 2)] = (va.y & 0xffffu) | (vb.y << 16); vt_[3 * (LP / 2)] = (va.y >> 16) | (vb.y & 0xffff0000u); \
        vt_[4 * (LP / 2)] = (va.z & 0xffffu) | (vb.z << 16); vt_[5 * (LP / 2)] = (va.z >> 16) | (vb.z & 0xffff0000u); \
        vt_[6 * (LP / 2)] = (va.w & 0xffffu) | (vb.w << 16); vt_[7 * (LP / 2)] = (va.w >> 16) | (vb.w & 0xffff0000u); } while (0)
    { int kt0; KB_INFO(0, kt0, pvalid); if (pvalid) { KV_PREFETCH(kt0); } }
    __syncthreads();
#pragma unroll
    for (int tq = 0; tq < 2; ++tq) { const int tok = (tq ? qtokB : qtokA) + qstr * srow; const u16* src = pbuf + (rowbase + tok) * DIN + qcol;
      u32x4 lo = *(const u32x4*)(src + 8 * sc), hi = *(const u32x4*)(src + 32 + 8 * sc);
      if (TYPE == 1) rope8(lo, hi, rtab + (size_t)tok * 32 + 8 * sc);
      *(u32x4*)(Qs + (tq * 64 + srow) * LP + 8 * sc) = lo; *(u32x4*)(Qs + (tq * 64 + srow) * LP + 32 + 8 * sc) = hi; }
    if (TYPE == 0) { const float* rpb = pp->in[7] + (size_t)(layer * 4 + h) * 465; for (int i = ht; i < 465; i += 256) Bs[i] = rpb[i] * LOG2E; }
    bool cvalid = pvalid;
    if (pvalid) { KV_STAGE(0); }
    { int kt0; KB_INFO(1, kt0, pvalid); if (pvalid) { KV_PREFETCH(kt0); } }
    const int qi = 16 * hw + fr;
    unsigned okm = 0xffffu; int bofs[16];
#pragma unroll
    for (int n = 0; n < 4; ++n)
#pragma unroll
        for (int j = 0; j < 4; ++j) { const int kj = 16 * n + 4 * fq + j;
            if (TYPE == 0) { const int cs = min(max(qi - 8, 0), 48); if (!((kj >= cs) && (kj < cs + 16))) okm &= ~(1u << (4 * n + j)); bofs[4 * n + j] = min(max(kj - qi, -15), 15) + 15; }
            else bofs[4 * n + j] = 0; }
    f32x4 o[2][4]; float mrow[2], lrow[2];
#pragma unroll
    for (int tq = 0; tq < 2; ++tq) { mrow[tq] = -INFINITY; lrow[tq] = 0.f;
#pragma unroll
        for (int i = 0; i < 4; ++i) o[tq][i] = (f32x4){0.f, 0.f, 0.f, 0.f}; }
    __syncthreads();
    bf16x8 aq[2][2];
#pragma unroll
    for (int tq = 0; tq < 2; ++tq) { aq[tq][0] = ldfrag(Qs + (tq * 64 + qi) * LP + fq * 8); aq[tq][1] = ldfrag(Qs + (tq * 64 + qi) * LP + 32 + fq * 8); }
    asm volatile("s_waitcnt lgkmcnt(0)" ::: "memory");
    const bool stag = (ht != (int)threadIdx.x);
    bool nvalid = false;
#define STAGE_NEXT() do { if (kb + 1 < nkb) { if (pvalid) { KV_STAGE((kb + 1) & 1); } nvalid = pvalid; \
        if (kb + 2 < nkb) { int kt0_; KB_INFO(kb + 2, kt0_, pvalid); if (pvalid) { KV_PREFETCH(kt0_); } } } } while (0)
#pragma unroll 2
    for (int kb = 0; kb < nkb; ++kb) {
        const u16* Kc = Ks + (kb & 1) * (2 * 64 * LP); const u16* Vc = Kc + 64 * LP;
        if (stag) { STAGE_NEXT(); }
        if (cvalid) {
#pragma unroll
            for (int tq = 0; tq < 2; ++tq) {
                bool act; int delta = 0, dr = 0;
                if (TYPE == 0) { const int krow = rsA + kb; const int rq = r + tq; const int rsq = tq ? rsB : rsA; act = (krow >= rsq) && (krow <= rsq + 7); dr = krow - rq; }
                else { delta = kb - 1 - tq; act = (delta >= -1) && (delta <= 1); }
                int ntlo = 0, nthi = 3;
                if (TYPE == 0) { const int klo_ = min(max(16 * hw - 8, 0), 48), khi_ = min(max(16 * hw + 15 - 8, 0), 48) + 15; ntlo = klo_ >> 4; nthi = khi_ >> 4; }
                else { if (delta < 0) ntlo = hw; else if (delta > 0) nthi = hw; }
                if (act) {
                    float bsv[16];
#pragma unroll
                    for (int i = 0; i < 16; ++i) bsv[i] = (TYPE == 0) ? Bs[(dr + 7) * 31 + bofs[i]] : 0.f;
                    f32x4 s[4];
                    __builtin_amdgcn_s_setprio(1);
#pragma unroll
                    for (int n = 0; n < 4; ++n) { s[n] = (f32x4){0.f, 0.f, 0.f, 0.f};
                        if (n >= ntlo && n <= nthi) {
                            s[n] = mfma16(ldfrag(Kc + (16 * n + fr) * LP + fq * 8), aq[tq][0], s[n]);
                            s[n] = mfma16(ldfrag(Kc + (16 * n + fr) * LP + 32 + fq * 8), aq[tq][1], s[n]); } }
                    __builtin_amdgcn_s_setprio(0);
                    float mx = -INFINITY;
#pragma unroll
                    for (int n = 0; n < 4; ++n)
#pragma unroll
                        for (int j = 0; j < 4; ++j) { const int kj = 16 * n + 4 * fq + j; bool ok; float v = s[n][j] * (0.125f * LOG2E);
                            if (TYPE == 0) { ok = (okm >> (4 * n + j)) & 1u; v += bsv[4 * n + j]; }
                            else { ok = (delta == 0) ? true : (delta < 0 ? (kj >= qi) : (kj <= qi)); }
                            v = ok ? v : -INFINITY; s[n][j] = v; mx = fmaxf(mx, v); }
                    mx = fmaxf(mx, __shfl_xor(mx, 16)); mx = fmaxf(mx, __shfl_xor(mx, 32));
                    const float mnew = fmaxf(mrow[tq], mx);
                    const float msafe = (mnew == -INFINITY) ? 0.f : mnew;
                    const float alpha = __builtin_amdgcn_exp2f(mrow[tq] - msafe);
                    float sum = 0.f;
#pragma unroll
                    for (int n = 0; n < 4; ++n) { float p[4];
#pragma unroll
                        for (int j = 0; j < 4; ++j) { p[j] = __builtin_amdgcn_exp2f(s[n][j] - msafe); sum += p[j]; }
                        uint2 w; w.x = cvtpk(p[0], p[1]); w.y = cvtpk(p[2], p[3]);
                        *(uint2*)(Ps + (tq * 64 + qi) * LP + 16 * n + 4 * fq) = w; }
                    sum += __shfl_xor(sum, 16); sum += __shfl_xor(sum, 32);
                    lrow[tq] = lrow[tq] * alpha + sum; mrow[tq] = mnew;
#pragma unroll
                    for (int nd = 0; nd < 4; ++nd) o[tq][nd] = o[tq][nd] * alpha;
                }
            }
            asm volatile("s_waitcnt lgkmcnt(0)" ::: "memory");
#pragma unroll
            for (int tq = 0; tq < 2; ++tq) {
                bool act; int delta = 0;
                if (TYPE == 0) { const int krow = rsA + kb; const int rsq = tq ? rsB : rsA; act = (krow >= rsq) && (krow <= rsq + 7); }
                else { delta = kb - 1 - tq; act = (delta >= -1) && (delta <= 1); }
                int ntlo = 0, nthi = 3;
                if (TYPE == 0) { const int klo_ = min(max(16 * hw - 8, 0), 48), khi_ = min(max(16 * hw + 15 - 8, 0), 48) + 15; ntlo = klo_ >> 4; nthi = khi_ >> 4; }
                else { if (delta < 0) ntlo = hw; else if (delta > 0) nthi = hw; }
                if (act) {
                    __builtin_amdgcn_s_setprio(1);
#pragma unroll
                    for (int kk = 0; kk < 2; ++kk) if (2 * kk + 1 >= ntlo && 2 * kk <= nthi) { const bf16x8 bp = ldfrag(Ps + (tq * 64 + qi) * LP + 32 * kk + fq * 8);
#pragma unroll
                        for (int nd = 0; nd < 4; ++nd) o[tq][nd] = mfma16(ldfrag(Vc + (16 * nd + fr) * LP + 32 * kk + fq * 8), bp, o[tq][nd]); }
                    __builtin_amdgcn_s_setprio(0);
                }
            }
        }
        if (!stag) { STAGE_NEXT(); }
        __syncthreads();
        cvalid = nvalid;
    }
#undef STAGE_NEXT
#undef KV_STAGE
#undef KB_INFO
#undef KV_PREFETCH
#pragma unroll
    for (int tq = 0; tq < 2; ++tq) { const int tok = (tq ? qtokB : qtokA) + qstr * qi; const float inv = rcpf_(lrow[tq]);
      u16* dst = (TYPE == 0) ? (u16*)(pp->ws + WS_H) + (rowbase + tok) * DM + 256 + h * 64 : (u16*)(pp->ws + WS_DAP) + ((size_t)br * MTOK + rowbase + tok) * 256 + h * 64;
#pragma unroll
      for (int nd = 0; nd < 4; ++nd) { uint2 w; w.x = cvtpk(o[tq][nd][0] * inv, o[tq][nd][1] * inv); w.y = cvtpk(o[tq][nd][2] * inv, o[tq][nd][3] * inv);
          *(uint2*)(dst + 16 * nd + 4 * fq) = w; }
      if (TYPE == 1 && fq == 0) ((float*)(pp->ws + WS_DAL))[((size_t)br * MTOK + rowbase + tok) * 4 + h] = (mrow[tq] + __log2f(lrow[tq])) * 0.6931471805599453f; }
}

constexpr int G1_ZS = 0;
constexpr int G1_WG = G1_ZS + 8192;
constexpr int G1_BG = G1_WG + 8192;
constexpr int G1_SEG = G1_BG + 512;
constexpr int G1_LA = G1_SEG + 4096;
constexpr int G1_T = G1_LA + 2 * 64 * FP * 4;
__device__ __forceinline__ void gla1_phase(int layer, unsigned char* lds, int tid, int bid, int G) {
    PP pp = get_pp();
    const int lane = tid & 63, w = __builtin_amdgcn_readfirstlane(tid >> 6), fr = lane & 15, fq = lane >> 4;
    float* ZS = (float*)(lds + G1_ZS); float* WG = (float*)(lds + G1_WG); float* BG = (float*)(lds + G1_BG); float* SEG = (float*)(lds + G1_SEG); float* LA = (float*)(lds + G1_LA);
    u16* KdT = (u16*)(lds + G1_T); u16* Vt = KdT + 2 * 64 * LP;
    const u16* pbuf = (const u16*)(pp->ws + WS_P);
    const int c = tid >> 3, part = tid & 7;
    int hc = -1;
    uint2 zz = make_uint2(0u, 0u); u32x4 kn = (u32x4){0u, 0u, 0u, 0u}, vn = kn;
#define GLA1_PREFETCH(u_) do { const int b_ = (u_) >> 9, n_ = ((u_) >> 2) & 127, h_ = (u_) & 3; const u16* r_ = pbuf + ((size_t)b_ * L_SEQ + n_ * 64 + c) * DIN; \
        zz = *(const uint2*)(r_ + C_ZA + 4 * part); kn = *(const u32x4*)(r_ + C_KA + h_ * 64 + 8 * part); vn = *(const u32x4*)(r_ + C_VA + h_ * 64 + 8 * part); } while (0)
    if (bid < 1024) GLA1_PREFETCH(bid);
#pragma unroll 1
    for (int uidx = bid; uidx < 1024; uidx += G) {
        const int b = uidx >> 9, n = (uidx >> 2) & 127, h = uidx & 3;
        const int sidx = b * 512 + h * 128 + n;
        __syncthreads();
        { float* z = ZS + c * 32 + 4 * part; z[0] = blo(zz.x); z[1] = bhi(zz.x); z[2] = blo(zz.y); z[3] = bhi(zz.y);
          if (h != hc) { hc = h;
#pragma unroll
              for (int q = 0; q < 4; ++q) { const int i = tid + 512 * q; const int e = i >> 10, rr = (i >> 6) & 15, ch = i & 63; WG[i] = pp->in[4][(((size_t)layer * 2 + e) * 16 + rr) * 256 + h * 64 + ch]; }
              if (tid < 128) { const int e = tid >> 6, ch = tid & 63; BG[tid] = pp->in[5][((size_t)layer * 2 + e) * 256 + h * 64 + ch]; } } }
        const u32x4 kv = kn, vv = vn;
        if (uidx + G < 1024) GLA1_PREFETCH(uidx + G);
        __syncthreads();
        const int ch = tid & 63, seg = __builtin_amdgcn_readfirstlane(tid >> 6);
        float la0[8], la1[8];
#pragma unroll
        for (int i = 0; i < 8; ++i) { const int cc = seg * 8 + i; float a0 = BG[ch], a1 = BG[64 + ch];
#pragma unroll
            for (int rr = 0; rr < 16; ++rr) { a0 += ZS[cc * 32 + rr] * WG[rr * 64 + ch]; a1 += ZS[cc * 32 + 16 + rr] * WG[1024 + rr * 64 + ch]; }
            la0[i] = logsigmoidf_(a0) * (1.f / 16.f); la1[i] = logsigmoidf_(a1) * (1.f / 16.f); }
#pragma unroll
        for (int i = 1; i < 8; ++i) la0[i] += la0[i - 1];
#pragma unroll
        for (int i = 6; i >= 0; --i) la1[i] += la1[i + 1];
        SEG[seg * 64 + ch] = la0[7]; SEG[512 + seg * 64 + ch] = la1[0];
        __syncthreads();
        { float pre0 = 0.f, pre1 = 0.f;
#pragma unroll
          for (int s2 = 0; s2 < 8; ++s2) { if (s2 < seg) pre0 += SEG[s2 * 64 + ch]; if (s2 > seg) pre1 += SEG[512 + s2 * 64 + ch]; }
          float* gb0 = (float*)(pp->ws + WS_GB) + (size_t)sidx * 4096; float* gb1 = gb0 + (size_t)1024 * 4096;
#pragma unroll
          for (int i = 0; i < 8; ++i) { const int cc = seg * 8 + i; const float v0 = la0[i] + pre0, v1 = la1[i] + pre1;
              LA[cc * FP + ch] = v0; LA[(64 + cc) * FP + ch] = v1; gb0[cc * 64 + ch] = v0; gb1[cc * 64 + ch] = v1; } }
        __syncthreads();
        if (tid < 128) { const int e = tid >> 6, k = tid & 63; ((float*)(pp->ws + WS_GDEC))[((size_t)e * 1024 + sidx) * 64 + k] = __expf(LA[(e * 64 + (e ? 0 : 63)) * FP + k]); }
        { float kf[8]; UNPACK8(kv, kf);
#pragma unroll
          for (int j = 0; j < 8; ++j) { const int k = 8 * part + j;
              KdT[k * LP + c] = (u16)f2bf(kf[j] * __expf(LA[63 * FP + k] - LA[c * FP + k]));
              KdT[(64 + k) * LP + c] = (u16)f2bf(kf[j] * __expf(LA[64 * FP + k] - LA[(64 + c) * FP + k])); }
          u16* vt = Vt + (8 * part) * LP + c; VT_SCATTER(vt, vv); }
        __syncthreads();
        { const int e = w >> 2, mt = w & 3;
          const bf16x8 a0 = ldfrag(KdT + (e * 64 + 16 * mt + fr) * LP + 8 * fq), a1 = ldfrag(KdT + (e * 64 + 16 * mt + fr) * LP + 32 + 8 * fq);
          float* kvout = (float*)(pp->ws + WS_GLA) + ((size_t)e * 1024 + sidx) * 4096;
#pragma unroll
          for (int nt = 0; nt < 4; ++nt) { f32x4 acc = (f32x4){0.f, 0.f, 0.f, 0.f};
              acc = mfma16(a0, ldfrag(Vt + (16 * nt + fr) * LP + 8 * fq), acc); acc = mfma16(a1, ldfrag(Vt + (16 * nt + fr) * LP + 32 + 8 * fq), acc);
#pragma unroll
              for (int j = 0; j < 4; ++j) kvout[(16 * mt + 4 * fq + j) * 64 + 16 * nt + fr] = acc[j]; } }
    }
#undef GLA1_PREFETCH
}

__device__ __forceinline__ void gla2_scan(int tid, int bid, int G) {
    PP pp = get_pp();
    float* KV = (float*)(pp->ws + WS_GLA); const float* DEC = (const float*)(pp->ws + WS_GDEC);
    if (tid >= 256) return;
    for (int idx = bid * 256 + tid; idx < 16 * 4096; idx += G * 256) {
        const int seq = idx >> 12, kvi = idx & 4095, k = kvi >> 6; const int e = seq >> 3;
        float S = 0.f;
#pragma unroll 32
        for (int i = 0; i < 128; ++i) { const int n = e ? 127 - i : i; const size_t u = (size_t)seq * 128 + n;
            const float t = KV[u * 4096 + kvi]; const float d = DEC[u * 64 + k]; KV[u * 4096 + kvi] = S; S = S * d + t; }
    }
}

constexpr int G3_TB = 64 * LP * 2;
constexpr int G3_OS = 11 * G3_TB;
__device__ __forceinline__ void gla3_phase(int layer, unsigned char* lds, int tid, int bid, int G) {
    PP pp = get_pp();
    const int lane = tid & 63, w = __builtin_amdgcn_readfirstlane(tid >> 6), fr = lane & 15, fq = lane >> 4;
    u16* T = (u16*)lds;
    u16* Vt = T + 10 * 64 * LP; float* OS = (float*)(lds + G3_OS);
    const u16* pbuf = (const u16*)(pp->ws + WS_P);
    const int c = tid >> 3, kc = tid & 7;
    u32x4 qn, kn, vn, gn; f32x4 bn[2][2], mn[2][2], sn[2][2];
#define GLA3_PREFETCH(u_) do { const int b_ = (u_) >> 9, n_ = ((u_) >> 2) & 127, h_ = (u_) & 3; const int s_ = b_ * 512 + h_ * 128 + n_; \
        const u16* r_ = pbuf + ((size_t)b_ * L_SEQ + n_ * 64 + c) * DIN + h_ * 64 + 8 * kc; \
        qn = *(const u32x4*)(r_ + C_QA); kn = *(const u32x4*)(r_ + C_KA); vn = *(const u32x4*)(r_ + C_VA); gn = *(const u32x4*)(r_ + C_GA); \
        _Pragma("unroll") for (int e_ = 0; e_ < 2; ++e_) { const float* gb_ = (const float*)(pp->ws + WS_GB) + ((size_t)e_ * 1024 + s_) * 4096; const float* sg_ = (const float*)(pp->ws + WS_GLA) + ((size_t)e_ * 1024 + s_) * 4096; \
            bn[e_][0] = __builtin_nontemporal_load((const f32x4*)(gb_ + c * 64 + 8 * kc)); bn[e_][1] = __builtin_nontemporal_load((const f32x4*)(gb_ + c * 64 + 8 * kc + 4)); \
            mn[e_][0] = *(const f32x4*)(gb_ + 32 * 64 + 8 * kc); mn[e_][1] = *(const f32x4*)(gb_ + 32 * 64 + 8 * kc + 4); \
            sn[e_][0] = __builtin_nontemporal_load((const f32x4*)(sg_ + c * 64 + 8 * kc)); sn[e_][1] = __builtin_nontemporal_load((const f32x4*)(sg_ + c * 64 + 8 * kc + 4)); } } while (0)
    if (bid < 1024) GLA3_PREFETCH(bid);
#pragma unroll 1
    for (int uidx = bid; uidx < 1024; uidx += G) {
        const int b = uidx >> 9, n = (uidx >> 2) & 127, h = uidx & 3;
        const size_t tok0 = (size_t)b * L_SEQ + n * 64;
        __syncthreads();
        { float qf[8], kf[8]; UNPACK8(qn, qf); UNPACK8(kn, kf);
#pragma unroll
          for (int e = 0; e < 2; ++e) {
              const f32x4 b0 = bn[e][0], b1 = bn[e][1], m0 = mn[e][0], m1 = mn[e][1];
              const float bv[8] = {b0.x, b0.y, b0.z, b0.w, b1.x, b1.y, b1.z, b1.w}; const float bm[8] = {m0.x, m0.y, m0.z, m0.w, m1.x, m1.y, m1.z, m1.w};
              float a[8], bb[8], cc[8];
#pragma unroll
              for (int j = 0; j < 8; ++j) { a[j] = qf[j] * 0.125f * __expf(bv[j] - bm[j]); bb[j] = kf[j] * __expf(bm[j] - bv[j]); cc[j] = qf[j] * 0.125f * __expf(bv[j]); }
              u32x4 o; PACK8(o, a); *(u32x4*)(T + ((0 + e) * 64 + c) * LP + 8 * kc) = o; PACK8(o, bb); *(u32x4*)(T + ((2 + e) * 64 + c) * LP + 8 * kc) = o; PACK8(o, cc); *(u32x4*)(T + ((4 + e) * 64 + c) * LP + 8 * kc) = o;
              const f32x4 s0 = sn[e][0], s1 = sn[e][1];
              u16* st = T + ((6 + e) * 64 + 8 * kc) * LP + c;
              st[0 * LP] = (u16)f2bf(s0.x); st[1 * LP] = (u16)f2bf(s0.y); st[2 * LP] = (u16)f2bf(s0.z); st[3 * LP] = (u16)f2bf(s0.w);
              st[4 * LP] = (u16)f2bf(s1.x); st[5 * LP] = (u16)f2bf(s1.y); st[6 * LP] = (u16)f2bf(s1.z); st[7 * LP] = (u16)f2bf(s1.w); }
          u16* vt = Vt + (8 * kc) * LP + c; VT_SCATTER(vt, vn); }
        const u32x4 gcur = gn;
        if (uidx + G < 1024) GLA3_PREFETCH(uidx + G);
        __syncthreads();
        { const int e = w >> 2, mt = w & 3;
          const u16* Qe = T + (0 + e) * 64 * LP; const u16* Ke = T + (2 + e) * 64 * LP; u16* At = T + (8 + e) * 64 * LP;
          const bf16x8 a0 = ldfrag(Qe + (16 * mt + fr) * LP + 8 * fq), a1 = ldfrag(Qe + (16 * mt + fr) * LP + 32 + 8 * fq);
#pragma unroll
          for (int nt = 0; nt < 4; ++nt) { f32x4 acc = (f32x4){0.f, 0.f, 0.f, 0.f};
              acc = mfma16(a0, ldfrag(Ke + (16 * nt + fr) * LP + 8 * fq), acc); acc = mfma16(a1, ldfrag(Ke + (16 * nt + fr) * LP + 32 + 8 * fq), acc);
#pragma unroll
              for (int j = 0; j < 4; ++j) { const int cq = 16 * mt + 4 * fq + j, s = 16 * nt + fr; const bool ok = (e == 0) ? (s <= cq) : (s >= cq);
                  At[cq * LP + s] = (u16)f2bf(ok ? acc[j] : 0.f); } } }
        __syncthreads();
        { const int mt = w >> 1;
          f32x4 oacc[2]; oacc[0] = (f32x4){0.f, 0.f, 0.f, 0.f}; oacc[1] = oacc[0];
#pragma unroll
          for (int e = 0; e < 2; ++e) { const u16* At = T + (8 + e) * 64 * LP; const u16* Qb = T + (4 + e) * 64 * LP; const u16* St = T + (6 + e) * 64 * LP;
#pragma unroll
              for (int kk = 0; kk < 2; ++kk) { const bf16x8 aA = ldfrag(At + (16 * mt + fr) * LP + 32 * kk + 8 * fq), aQ = ldfrag(Qb + (16 * mt + fr) * LP + 32 * kk + 8 * fq);
#pragma unroll
                  for (int t = 0; t < 2; ++t) { const int nt = (w & 1) * 2 + t;
                      oacc[t] = mfma16(aA, ldfrag(Vt + (16 * nt + fr) * LP + 32 * kk + 8 * fq), oacc[t]);
                      oacc[t] = mfma16(aQ, ldfrag(St + (16 * nt + fr) * LP + 32 * kk + 8 * fq), oacc[t]); } } }
#pragma unroll
          for (int t = 0; t < 2; ++t) { const int nt = (w & 1) * 2 + t;
#pragma unroll
              for (int j = 0; j < 4; ++j) OS[(16 * mt + 4 * fq + j) * FP + 16 * nt + fr] = oacc[t][j]; } }
        __syncthreads();
        { float ov[8]; float ss = 0.f;
#pragma unroll
          for (int j = 0; j < 8; ++j) { ov[j] = OS[c * FP + 8 * kc + j]; ss += ov[j] * ov[j]; }
          ss += __shfl_xor(ss, 1); ss += __shfl_xor(ss, 2); ss += __shfl_xor(ss, 4);
          const float rs = rsqrtf(ss * (1.f / 64.f) + EPS);
          float gf[8]; UNPACK8(gcur, gf);
          const float* ng = pp->in[6] + (size_t)layer * 256 + h * 64 + 8 * kc;
#pragma unroll
          for (int j = 0; j < 8; ++j) ov[j] = ov[j] * rs * ng[j] * (gf[j] * sigmoidf_(gf[j]));
          u32x4 o; PACK8(o, ov);
          *(u32x4*)((u16*)(pp->ws + WS_H) + (tok0 + c) * DM + h * 64 + 8 * kc) = o; }
    }
#undef GLA3_PREFETCH
}

constexpr int LR_XF = 0;
constexpr int LR_XB = LR_XF + 64 * FP * 4;
constexpr int LR_A = LR_XB + 64 * LP * 2;
constexpr int LR_U = LR_A + 2 * 64 * FP * 4;
constexpr int LR_END = LR_U + 2 * 64 * FP * 4;
template <int PASS>
__device__ __forceinline__ void lru_phase(int layer, unsigned char* lds, int tid, int bid, int G) {
    PP pp = get_pp();
    const int lane = tid & 63, w = __builtin_amdgcn_readfirstlane(tid >> 6), fr = lane & 15, fq = lane >> 4;
    float* XF = (float*)(lds + LR_XF); u16* XB = (u16*)(lds + LR_XB); float* AS = (float*)(lds + LR_A); float* US = (float*)(lds + LR_U);
    const u16* pbuf = (const u16*)(pp->ws + WS_P);
    const int t = tid >> 3, cc = tid & 7;
    const int mt = w & 3, e = w >> 2;
    int hc = -1;
    bf16x8 wa[4][2], wx[4][2]; float ba[4], bx[4], sp[4], cw[4][8], cb[8];
    u32x4 xt[4], gnext = (u32x4){0u, 0u, 0u, 0u};
#define LRU_PREFETCH(u_) do { const int b_ = (u_) >> 9, n_ = ((u_) >> 2) & 127, h_ = (u_) & 3; const size_t rb_ = (size_t)b_ * L_SEQ; \
        _Pragma("unroll") for (int jj = 0; jj < 4; ++jj) { const int tt_ = n_ * 64 + t - 2 + jj; \
            xt[jj] = (tt_ >= 0 && tt_ < L_SEQ) ? *(const u32x4*)(pbuf + (rb_ + tt_) * DIN + C_XC + h_ * 64 + 8 * cc) : (u32x4){0u, 0u, 0u, 0u}; } \
        if (PASS == 3) gnext = *(const u32x4*)(pbuf + (rb_ + n_ * 64 + t) * DIN + C_GC + h_ * 64 + 8 * cc); } while (0)
    if (bid < 1024) LRU_PREFETCH(bid);
#pragma unroll 1
    for (int uidx = bid; uidx < 1024; uidx += G) {
        const int b = uidx >> 9, n = (uidx >> 2) & 127, h = uidx & 3;
        const size_t rowbase = (size_t)b * L_SEQ; const int t0 = n * 64;
        if (h != hc) { hc = h;
            const u16* WA = (const u16*)(pp->ws + WS_LRUW) + ((((size_t)layer * 2 + 0) * 2 + e) * 4 + h) * 4096;
            const u16* WX = (const u16*)(pp->ws + WS_LRUW) + ((((size_t)layer * 2 + 1) * 2 + e) * 4 + h) * 4096;
#pragma unroll
            for (int nt = 0; nt < 4; ++nt) { const int jc = 16 * nt + fr; const int chg = h * 64 + jc;
                wa[nt][0] = ldfrag(WA + jc * 64 + 8 * fq); wa[nt][1] = ldfrag(WA + jc * 64 + 32 + 8 * fq);
                wx[nt][0] = ldfrag(WX + jc * 64 + 8 * fq); wx[nt][1] = ldfrag(WX + jc * 64 + 32 + 8 * fq);
                ba[nt] = pp->in[11][((size_t)layer * 2 + e) * 256 + chg]; bx[nt] = pp->in[13][((size_t)layer * 2 + e) * 256 + chg];
                sp[nt] = softplusf_(-pp->in[14][((size_t)layer * 2 + e) * 256 + chg]); }
#pragma unroll
            for (int j = 0; j < 8; ++j) { cb[j] = pp->in[9][(size_t)layer * 256 + h * 64 + 8 * cc + j];
#pragma unroll
                for (int jj = 0; jj < 4; ++jj) cw[jj][j] = pp->in[8][((size_t)layer * 4 + jj) * 256 + h * 64 + 8 * cc + j]; } }
        __syncthreads();
        { float acc[8];
#pragma unroll
          for (int j = 0; j < 8; ++j) acc[j] = cb[j];
#pragma unroll
          for (int jj = 0; jj < 4; ++jj) { float xf[8]; UNPACK8(xt[jj], xf);
#pragma unroll
              for (int j = 0; j < 8; ++j) acc[j] += xf[j] * cw[jj][j]; }
#pragma unroll
          for (int j = 0; j < 8; ++j) XF[t * FP + 8 * cc + j] = acc[j];
          u32x4 o; PACK8(o, acc); *(u32x4*)(XB + t * LP + 8 * cc) = o; }
        const u32x4 gcur = gnext;
        float hin = 0.f; size_t cidx = 0;
        if (tid < 128) { const int e2 = tid >> 6, ch = tid & 63; cidx = ((size_t)(e2 * 2 + b) * 128 + n) * 256 + h * 64 + ch; if (PASS == 3) hin = ((const float*)(pp->ws + WS_LRUH))[cidx]; }
        if (uidx + G < 1024) LRU_PREFETCH(uidx + G);
        __syncthreads();
        { const bf16x8 a0 = ldfrag(XB + (16 * mt + fr) * LP + 8 * fq), a1 = ldfrag(XB + (16 * mt + fr) * LP + 32 + 8 * fq);
#pragma unroll
          for (int nt = 0; nt < 4; ++nt) { const int jc = 16 * nt + fr;
              f32x4 ar = (f32x4){0.f, 0.f, 0.f, 0.f}, ai = ar;
              ar = mfma16(a0, wa[nt][0], ar); ar = mfma16(a1, wa[nt][1], ar);
              ai = mfma16(a0, wx[nt][0], ai); ai = mfma16(a1, wx[nt][1], ai);
#pragma unroll
              for (int j = 0; j < 4; ++j) { const int tt = 16 * mt + 4 * fq + j;
                  const float rg = sigmoidf_(ar[j] + ba[nt]), ig = sigmoidf_(ai[j] + bx[nt]);
                  const float la = -8.f * rg * sp[nt]; const float a = __expf(la); const float u = __builtin_amdgcn_sqrtf(fmaxf(1.f - a * a, 0.f)) * (ig * XF[tt * FP + jc]);
                  AS[(e * 64 + tt) * FP + jc] = a; US[(e * 64 + tt) * FP + jc] = u; } } }
        __syncthreads();
        if (tid < 128) { const int e2 = tid >> 6, ch = tid & 63;
            if (PASS == 1) { float Pp = 1.f, H = 0.f;
#pragma unroll 16
                for (int i = 0; i < 64; ++i) { const int tt = e2 ? 63 - i : i; const float a = AS[(e2 * 64 + tt) * FP + ch], u = US[(e2 * 64 + tt) * FP + ch]; Pp *= a; H = a * H + u; }
                ((float*)(pp->ws + WS_LRUA))[cidx] = Pp; ((float*)(pp->ws + WS_LRUH))[cidx] = H; }
            else { float H = hin;
#pragma unroll 16
                for (int i = 0; i < 64; ++i) { const int tt = e2 ? 63 - i : i; const float a = AS[(e2 * 64 + tt) * FP + ch], u = US[(e2 * 64 + tt) * FP + ch]; H = a * H + u; US[(e2 * 64 + tt) * FP + ch] = H; } } }
        if (PASS == 3) {
            __syncthreads();
            float gf[8], ov[8]; UNPACK8(gcur, gf);
#pragma unroll
            for (int j = 0; j < 8; ++j) ov[j] = (US[t * FP + 8 * cc + j] + US[(64 + t) * FP + 8 * cc + j]) * gelu_tanh(gf[j]);
            u32x4 o; PACK8(o, ov);
            *(u32x4*)((u16*)(pp->ws + WS_H) + (rowbase + t0 + t) * DM + 512 + h * 64 + 8 * cc) = o;
        }
    }
#undef LRU_PREFETCH
}
__device__ __forceinline__ void lru2_scan(int tid, int bid, int G) {
    PP pp = get_pp();
    const float* A = (const float*)(pp->ws + WS_LRUA); float* Hh = (float*)(pp->ws + WS_LRUH);
    if (tid < 256) return;
    for (int idx = (tid - 256) * G + bid; idx < 2 * 2 * 256; idx += 256 * G) { const int ch = idx & 255, eb = idx >> 8, e = eb >> 1;
        float H = 0.f;
#pragma unroll 32
        for (int i = 0; i < 128; ++i) { const int n = e ? 127 - i : i; const size_t c = ((size_t)eb * 128 + n) * 256 + ch; const float a = A[c], hl = Hh[c]; Hh[c] = H; H = a * H + hl; } }
}
__device__ __forceinline__ void da_combine(int gt, int ngt) {
    PP pp = get_pp();
    const u16* dap = (const u16*)(pp->ws + WS_DAP); const float* dal = (const float*)(pp->ws + WS_DAL); u16* y = (u16*)(pp->ws + WS_H);
    constexpr int NI = 4;
    for (int idx0 = gt; idx0 < MTOK * 32; idx0 += NI * ngt) {
        u32x4 v[NI][3]; float l[NI][3]; bool has[NI]; int tok[NI], c[NI];
#pragma unroll
        for (int q = 0; q < NI; ++q) { const int idx = idx0 + q * ngt; has[q] = idx < MTOK * 32; const int id2 = has[q] ? idx : idx0; tok[q] = id2 >> 5; c[q] = id2 & 31; const int h = c[q] >> 3;
#pragma unroll
            for (int g = 0; g < 3; ++g) { l[q][g] = dal[((size_t)g * MTOK + tok[q]) * 4 + h]; v[q][g] = __builtin_nontemporal_load((const u32x4*)(dap + ((size_t)g * MTOK + tok[q]) * 256 + 8 * c[q])); } }
#pragma unroll
        for (int q = 0; q < NI; ++q) {
            const float mx = fmaxf(l[q][0], fmaxf(l[q][1], l[q][2])); float w0 = __expf(l[q][0] - mx), w1 = __expf(l[q][1] - mx), w2 = __expf(l[q][2] - mx); const float inv = rcpf_(w0 + w1 + w2); w0 *= inv; w1 *= inv; w2 *= inv;
            float f0[8], f1[8], f2[8], ov[8]; UNPACK8(v[q][0], f0); UNPACK8(v[q][1], f1); UNPACK8(v[q][2], f2);
#pragma unroll
            for (int j = 0; j < 8; ++j) ov[j] = w0 * f0[j] + w1 * f1[j] + w2 * f2[j];
            u32x4 o; PACK8(o, ov);
            if (has[q]) *(u32x4*)(y + (size_t)tok[q] * DM + 768 + 8 * c[q]) = o; }
    }
}

#define LAS __attribute__((address_space(3)))
#define XB_TMO      128
#define XB_XCNT(j)  (256  + 64 * (j))
#define XB_XSUB(j)  (1280 + 64 * (j))
#define XB_XGEN(j)  (2304 + 64 * (j))
#define XB_TOP      3328
#define XB_TOPGEN   3392
#define XCD_BAR_WORDS 3456
#define XB_SPIN_CAP (1u << 18)

__device__ __forceinline__ unsigned xb_ld(unsigned* p)              { return __hip_atomic_load(p, __ATOMIC_RELAXED, __HIP_MEMORY_SCOPE_AGENT); }
__device__ __forceinline__ unsigned xb_add(unsigned* p, unsigned v) { return __hip_atomic_fetch_add(p, v, __ATOMIC_RELAXED, __HIP_MEMORY_SCOPE_AGENT); }
__device__ __forceinline__ unsigned xb_xcc_id() { return (unsigned)__builtin_amdgcn_s_getreg((3 << 11) | 20) & 0xFu; }
#define XB_SPIN(cond, bar) do { unsigned _sp = 0; while (cond) { __builtin_amdgcn_s_sleep(1); \
    if ((++_sp & 255u) == 0u) { if (xb_ld(&(bar)[XB_TMO])) break; if (_sp > XB_SPIN_CAP) { atomicAdd(&(bar)[XB_TMO], 1u); break; } } } } while (0)

struct XcdBarrier {
    unsigned* bar; unsigned x;
    volatile LAS unsigned* st;
};

__device__ __forceinline__ XcdBarrier xcd_barrier_post(unsigned* bar, volatile LAS unsigned* st) {
    XcdBarrier b; b.bar = bar; b.x = xb_xcc_id(); b.st = st;
    if (threadIdx.x == 0) (void)xb_add(&bar[XB_XCNT(b.x)], 1u);
    return b;
}
__device__ __forceinline__ void xcd_barrier_complete(unsigned* bar, unsigned x, unsigned& nloc, unsigned& nx) {
    const unsigned G = gridDim.x * gridDim.y * gridDim.z;
    unsigned sum, cnt, mine, sp = 0u;
    for (;;) {
        sum = 0u; cnt = 0u; mine = 0u;
#pragma unroll
        for (unsigned j = 0; j < 16; ++j) { const unsigned c = xb_ld(&bar[XB_XCNT(j)]); sum += c; cnt += (c > 0u) ? 1u : 0u; mine = (j == x) ? c : mine; }
        if (sum == G) break;
        __builtin_amdgcn_s_sleep(1);
        if ((++sp & 255u) == 0u) { if (xb_ld(&bar[XB_TMO])) break; if (sp > XB_SPIN_CAP) { atomicAdd(&bar[XB_TMO], 1u); break; } }
    }
    nloc = mine > 0u ? mine : 1u; nx = cnt > 0u ? cnt : 1u;
}

__device__ __forceinline__ void xcd_barrier(const XcdBarrier& b) {
    asm volatile("s_waitcnt vmcnt(0)" ::: "memory");
    __syncthreads();
    if (threadIdx.x == 0) {
        unsigned* bar = b.bar;
        __builtin_amdgcn_s_waitcnt(0);
        unsigned nloc = b.st[0], nx = b.st[1];
        if (nloc == 0u) { xcd_barrier_complete(bar, b.x, nloc, nx); b.st[0] = nloc; b.st[1] = nx; }
        const unsigned old = xb_add(&bar[XB_XSUB(b.x)], 1u);
        const unsigned gen = old / nloc;
        if (old + 1u == (gen + 1u) * nloc) {
            __builtin_amdgcn_fence(__ATOMIC_RELEASE, "agent");
            asm volatile("s_waitcnt vmcnt(0)" ::: "memory");
            const unsigned og = xb_add(&bar[XB_TOP], 1u);
            const unsigned tg = og / nx;
            if (og + 1u == (tg + 1u) * nx) xb_add(&bar[XB_TOPGEN], 1u);
            else XB_SPIN(xb_ld(&bar[XB_TOPGEN]) == tg, bar);
            __builtin_amdgcn_fence(__ATOMIC_ACQUIRE, "agent");
            xb_add(&bar[XB_XGEN(b.x)], 1u);
            asm volatile("s_waitcnt vmcnt(0)" ::: "memory");
        } else {
            XB_SPIN(xb_ld(&bar[XB_XGEN(b.x)]) == gen, bar);
            __builtin_amdgcn_fence(__ATOMIC_ACQUIRE, "agent");
            asm volatile("s_waitcnt vmcnt(0)" ::: "memory");
        }
    }
    __syncthreads();
}


#define R_G 1
#define R_PRO 1
#define PROBE_MASK 0
#define XSYNC 0
#define R_NA 1
#define R_DA 1
#define R_GLA1 1
#define R_LRU1 1
#define R_GLA3 1
#define R_LRU3 1
#define R_DAC 1
__global__ void __launch_bounds__(NTHR, 2) hybrid_fwd(Params P) {
    extern __shared__ __attribute__((aligned(16))) unsigned char lds_raw[];
    cg::grid_group grid = cg::this_grid();
    const int ph_lo = P.ph_lo, ph_hi = P.ph_hi;
    int again = 0;
    { volatile LAS unsigned* st0 = (volatile LAS unsigned*)((LAS unsigned char*)lds_raw + (LDS_BYTES - 256));
      if (threadIdx.x < 2) st0[threadIdx.x] = 0u;
      __syncthreads();
      (void)xcd_barrier_post((unsigned*)(P.ws + WS_CTL), st0); }
#define GSYNC() do { XcdBarrier xb_; xb_.bar = (unsigned*)(get_pp()->ws + WS_CTL); xb_.x = xb_xcc_id(); xb_.st = (volatile LAS unsigned*)((LAS unsigned char*)lds_raw + (LDS_BYTES - 256)); xcd_barrier(xb_); } while (0)
    for (int ph = ph_lo; ph < ph_hi; ++ph) {
        PP pp = get_pp(); unsigned char* ws = pp->ws;
        int tid = threadIdx.x; asm volatile("" : "+v"(tid));
        int bid = blockIdx.x; asm volatile("" : "+s"(bid));
        int G = gridDim.x; asm volatile("" : "+s"(G));
        PG8_LAS unsigned char* l3 = (PG8_LAS unsigned char*)lds_raw; asm volatile("" : "+s"(l3));
        unsigned char* lds = (unsigned char*)l3;
        const int lane = tid & 63, wave = __builtin_amdgcn_readfirstlane(tid >> 6);
        const int gw = bid * 8 + wave, ngw = G * 8;
        const int gt = bid * NTHR + tid, ngt = G * NTHR;
        if (ph == 0) { for (int rep = 0; rep < R_PRO; ++rep) prologue(tid, lane, wave, bid, G, lds); }
        else {
            const int l = (ph - 1) / 9, t = (ph - 1) % 9;
            const bool fusedn = FUSE_NORM && (G == 256);
            if (fusedn && (t == 5 || t == 8)) continue;
            if (fusedn && (t == 4 || t == 7)) {
                pg8::Gemm g; pg8::EpiRms2 E;
                const int inst = l * 2 + (t == 7);
                pg8::PanelStats s1{(unsigned*)(ws + WS_XB), (unsigned*)(ws + WS_CTL + CTL_SEAM) + (size_t)(inst * 2 + 0) * 4096, (unsigned*)(ws + WS_CTL + CTL_TMO), DM / 256, EPS, 0x700u};
                pg8::PanelStats s2{(unsigned*)(ws + WS_XB + 524288), (unsigned*)(ws + WS_CTL + CTL_SEAM) + (size_t)(inst * 2 + 1) * 4096, (unsigned*)(ws + WS_CTL + CTL_TMO), DM / 256, EPS, 0x780u};
                if (t == 4) { g = pg8::Gemm{(const u16*)(ws + WS_H), (const u16*)(ws + WS_WOUT) + (size_t)l * DM * DM, MTOK, DM, DM};
                    E = pg8::EpiRms2{l == 0 ? pp->in[0] : pp->out, pp->out, (u16*)(ws + WS_H), DM, pp->in[2] + (size_t)l * DM, pp->in[16] + (size_t)l * DM, s1, s2}; }
                else { g = pg8::Gemm{(const u16*)(ws + WS_P), (const u16*)(ws + WS_WF2) + (size_t)l * DM * DFF, MTOK, DM, DFF};
                    E = pg8::EpiRms2{pp->out, pp->out, (u16*)(ws + WS_H), DM, pp->in[17] + (size_t)l * DM, pp->in[1] + (size_t)(l + 1 < DEPTH ? l + 1 : l) * DM, s1, s2}; }
                pg8::StaticOrder S; S.init(g.M, g.N, G, bid);
                pg8::gemm_phase<pg8::EpiRms2, pg8::StaticOrder, false, true>(l3, g, S, E, tid);
            } else
#ifndef SKIP_G1
            if (t == 0 || t == 4 || t == 7) {
                pg8::Gemm g; pg8::EpiStore E;
                if (t == 0) { g = pg8::Gemm{(const u16*)(ws + WS_H), (const u16*)(ws + WS_WIN) + (size_t)l * DIN_PAD * DM, MTOK, ZSPLIT ? 3072 : DIN_PAD, DM}; E = ZSPLIT ? pg8::EpiStore{(u16*)(ws + WS_P), DIN, 3072, 1024, 32} : pg8::EpiStore{(u16*)(ws + WS_P), DIN, DIN, 1 << 30, 0}; }
                else if (t == 4) { g = pg8::Gemm{(const u16*)(ws + WS_H), (const u16*)(ws + WS_WOUT) + (size_t)l * DM * DM, MTOK, DM, DM}; E = pg8::EpiStore{(u16*)(ws + WS_P), DM, DM, 1 << 30, 0}; }
                else { g = pg8::Gemm{(const u16*)(ws + WS_P), (const u16*)(ws + WS_WF2) + (size_t)l * DM * DFF, MTOK, DM, DFF}; E = pg8::EpiStore{(u16*)(ws + WS_GLA), DM, DM, 1 << 30, 0}; }
                pg8::StaticOrder S; S.init(g.M, g.N, G, bid);
                for (int rep = 0; rep < R_G; ++rep) pg8::gemm_phase<pg8::EpiStore, pg8::StaticOrder, true, true>(l3, g, S, E, tid);
                if (ZSPLIT && t == 0) {
                    const int w = __builtin_amdgcn_readfirstlane(tid >> 6), fr = lane & 15, fq = lane >> 4, mt = w & 3, kh = w >> 2;
                    float* red = (float*)lds;
                    for (int rb = bid; rb < MTOK / 64; rb += G) {
                        const u16* A = (const u16*)(ws + WS_H) + (size_t)(rb * 64 + 16 * mt + fr) * DM + kh * 512 + 8 * fq;
                        const u16* B0 = (const u16*)(ws + WS_WIN) + ((size_t)l * DIN_PAD + 3072 + fr) * DM + kh * 512 + 8 * fq; const u16* B1 = B0 + 16 * DM;
                        f32x4 z0 = (f32x4){0.f, 0.f, 0.f, 0.f}, z1 = z0;
#pragma unroll
                        for (int hb = 0; hb < 2; ++hb) {
                            bf16x8 av[8], b0v[8], b1v[8];
#pragma unroll
                            for (int s = 0; s < 8; ++s) { av[s] = ldfrag(A + 32 * (8 * hb + s)); b0v[s] = ldfrag(B0 + 32 * (8 * hb + s)); b1v[s] = ldfrag(B1 + 32 * (8 * hb + s)); }
                            __builtin_amdgcn_sched_barrier(0);
#pragma unroll
                            for (int s = 0; s < 8; ++s) { z0 = mfma16(av[s], b0v[s], z0); z1 = mfma16(av[s], b1v[s], z1); }
                        }
                        __syncthreads();
                        if (kh == 1) {
#pragma unroll
                            for (int j = 0; j < 4; ++j) { red[(16 * mt + 4 * fq + j) * 33 + fr] = z0[j]; red[(16 * mt + 4 * fq + j) * 33 + 16 + fr] = z1[j]; } }
                        __syncthreads();
                        if (kh == 0) { u16* pz = (u16*)(ws + WS_P) + (size_t)(rb * 64 + 16 * mt + 4 * fq) * DIN + C_ZA;
#pragma unroll
                            for (int j = 0; j < 4; ++j) { pz[(size_t)j * DIN + fr] = (u16)f2bf(z0[j] + red[(16 * mt + 4 * fq + j) * 33 + fr]); pz[(size_t)j * DIN + 16 + fr] = (u16)f2bf(z1[j] + red[(16 * mt + 4 * fq + j) * 33 + 16 + fr]); } }
                    }
                }
            } else
#endif
#ifndef SKIP_G3
            if (t == 6) {
                pg8::Gemm g{(const u16*)(ws + WS_H), (const u16*)(ws + WS_WF1) + (size_t)l * 2 * DFF * DM, MTOK, 2 * DFF, DM};
                pg8::EpiSwiGLU E{(u16*)(ws + WS_P), DFF};
                pg8::StaticOrder S; S.init(g.M, g.N, G, bid);
                for (int rep = 0; rep < R_G; ++rep) pg8::gemm_phase<pg8::EpiSwiGLU, pg8::StaticOrder, true, true>(l3, g, S, E, tid);
            } else
#endif
#ifndef SKIP_M1
            if (t == 1) {
                const int half = tid >> 8, ht = tid & 255; unsigned char* hl = lds + half * ATT_HALF_BYTES;
                for (int rep = 0; rep < R_NA; ++rep) for (int pi = bid; pi < 256; pi += G) attn_unit<0>(l, 2 * pi + half, hl, ht);
                for (int rep = 0; rep < R_DA; ++rep) for (int pi = bid; pi < 768; pi += G) attn_unit<1>(l, 2 * pi + half, hl, ht);
                for (int rep = 0; rep < R_GLA1; ++rep) gla1_phase(l, lds, tid, bid, G);
                for (int rep = 0; rep < R_LRU1; ++rep) lru_phase<1>(l, lds, tid, bid, G);
            } else
#endif
            if (t == 2) {
                gla2_scan(tid, bid, G);
                lru2_scan(tid, bid, G);
            } else
#ifndef SKIP_M3
            if (t == 3) {
                for (int rep = 0; rep < R_GLA3; ++rep) gla3_phase(l, lds, tid, bid, G);
                for (int rep = 0; rep < R_LRU3; ++rep) lru_phase<3>(l, lds, tid, bid, G);
                for (int rep = 0; rep < R_DAC; ++rep) da_combine(gt, ngt);
            } else
#endif
            if (t == 5) {
                row_pass(1, l == 0 ? pp->in[0] : pp->out, pp->out, (const u16*)(ws + WS_P), pp->in[2] + (size_t)l * DM, pp->in[16] + (size_t)l * DM, (u16*)(ws + WS_H), gw, ngw, lane);
            } else if (t == 8) {
                row_pass(1, pp->out, pp->out, (const u16*)(ws + WS_GLA), pp->in[17] + (size_t)l * DM, (l + 1 < DEPTH) ? pp->in[1] + (size_t)(l + 1) * DM : nullptr, (u16*)(ws + WS_H), gw, ngw, lane);
            }
        }
        if (PROBE_MASK && ph > 0 && ((PROBE_MASK >> ((ph - 1) % 9)) & 1) && !again) { again = 1; --ph; GSYNC(); continue; }
        again = 0;
        for (int xs = 0; xs < XSYNC; ++xs) GSYNC();
        if (ph + 1 < ph_hi) { if (ph_hi > 4096) grid.sync();
            GSYNC(); }
    }
}

#ifndef N_LAUNCH_MODE
#define N_LAUNCH_MODE 1
#endif
constexpr int N_PHASES = 1 + 9 * DEPTH;
extern "C" void kernel_launch(void* const* d_in, const int* in_sizes, int n_in, void* d_out, int out_size, void* d_ws, size_t ws_size, hipStream_t stream) {
    static int grid = 0;
    if (grid == 0) {
        if (n_in != 20 || ws_size < WS_END) { fprintf(stderr, "kernel_launch: need 20 inputs and %zu B workspace (got %d, %zu)\n", (size_t)WS_END, n_in, ws_size); grid = -1; return; }
        int dev = 0, cus = 0, per_cu = 0;
        hipGetDevice(&dev); hipDeviceGetAttribute(&cus, hipDeviceAttributeMultiprocessorCount, dev);
        if (hipFuncSetAttribute((const void*)hybrid_fwd, hipFuncAttributeMaxDynamicSharedMemorySize, LDS_BYTES) != hipSuccess) { fprintf(stderr, "hipFuncSetAttribute failed\n"); grid = -1; return; }
        if (hipOccupancyMaxActiveBlocksPerMultiprocessor(&per_cu, (const void*)hybrid_fwd, NTHR, LDS_BYTES) != hipSuccess || per_cu < 1) { fprintf(stderr, "occupancy query: %d\n", per_cu); per_cu = 1; }
        (void)hipGetLastError();
        grid = cus * 1;
        if (per_cu < 1) grid = -1;
    }
    if (grid < 0) return;
    if (hipMemsetAsync((char*)d_ws + WS_CTL, 0, CTL_BYTES, stream) != hipSuccess) { fprintf(stderr, "memset failed\n"); return; }
    Params p{};
    for (int i = 0; i < 20; ++i) p.in[i] = (const float*)d_in[i];
    p.out = (float*)d_out; p.ws = (unsigned char*)d_ws;
#if N_LAUNCH_MODE == 1
    p.ph_lo = 0; p.ph_hi = N_PHASES;
    { void* args[] = {&p}; hipError_t e = hipLaunchCooperativeKernel((const void*)hybrid_fwd, dim3(grid), dim3(NTHR), args, LDS_BYTES, stream);
      if (e != hipSuccess) fprintf(stderr, "cooperative launch failed: %s\n", hipGetErrorString(e)); }
#else
    for (int ph = 0; ph < N_PHASES; ++ph) { p.ph_lo = ph; p.ph_hi = ph + 1; void* args[] = {&p};
        hipError_t e = hipLaunchCooperativeKernel((const void*)hybrid_fwd, dim3(grid), dim3(NTHR), args, LDS_BYTES, stream);
        if (e != hipSuccess) { fprintf(stderr, "launch %d failed: %s\n", ph, hipGetErrorString(e)); break; } }
#endif
}
```

```cpp
#include <hip/hip_runtime.h>
#include <hip/hip_cooperative_groups.h>
#include <cstdio>
#include <cstdint>
namespace cg = cooperative_groups;
namespace pg8 {
#define PG8_LAS __attribute__((address_space(3)))
typedef unsigned short bf16_t;
typedef short bf16x8 __attribute__((ext_vector_type(8)));
typedef float f32x4 __attribute__((ext_vector_type(4)));
typedef unsigned u32x4 __attribute__((ext_vector_type(4)));
constexpr int BM = 256, BK = 64, HALF = 128, HTB = HALF * BK * 2  , STAGE_BYTES = 8 * HTB, NXCD = 8, WGM = 8;

__host__ __device__ __forceinline__ int lds_byte(int r, int c) { const int st = (r >> 4) * 2 + (c >> 5), rr = r & 15, cc = c & 31, ob = rr * 64 + cc * 2; return st * 1024 + (ob ^ (((ob >> 9) & 1) << 5)); }
__host__ __device__ __forceinline__ void stage_rc(int b, int& R, int& C) { const int st = b / 1024, sb = b % 1024, swz = sb ^ (((sb >> 9) & 1) << 5); R = (st >> 1) * 16 + swz / 64; C = (st & 1) * 32 + (swz % 64) / 2; }
__host__ __device__ __forceinline__ int perm32(int rho) { const int n = rho >> 4, i = rho & 15; return 8 * (i >> 2) + 4 * n + (i & 3); }

struct Unit { int pm, pn; };
struct Gemm { const bf16_t* A; const bf16_t* Bt; int M, N, K; };

struct StaticOrder {
    int nM, nN, nwg, G, c;
    __host__ __device__ void init(int M, int N, int G_, int c_) { nM = M / BM; nN = N / BM; nwg = nM * nN; G = G_; c = c_; }
    __host__ __device__ bool next(int i, Unit& u) const {
        const long L = (long)i * G + c; if (L >= nwg) return false;
        int wgid = (int)L; { const int q = nwg / NXCD, r = nwg % NXCD, xcd = wgid % NXCD, off = wgid / NXCD; wgid = (xcd < r ? xcd * (q + 1) : r * (q + 1) + (xcd - r) * q) + off; }
        const int nig = WGM * nN, gid = wgid / nig, fm = gid * WGM, gsz = (nM - fm) < WGM ? (nM - fm) : WGM;
        u.pm = fm + ((wgid % nig) % gsz); u.pn = (wgid % nig) / gsz; return true;
    }
    __device__ __forceinline__ void a_ready(const Unit&) const {}
    __device__ __forceinline__ void done(const Unit&) const {}
};

__device__ __forceinline__ unsigned cvt_pk_bf16(float lo, float hi) { unsigned r; asm volatile("v_cvt_pk_bf16_f32 %0, %1, %2" : "=v"(r) : "v"(lo), "v"(hi)); return r; }
template <class Epi, class Sched, bool ALIGN_EPI = false, bool SP2 = false>
__device__ __forceinline__ void gemm_phase(PG8_LAS unsigned char* lds, const Gemm g, const Sched& S, const Epi& E, const int tid) {
    const int wid = __builtin_amdgcn_readfirstlane(tid >> 6), lane = tid & 63, wr = wid >> 2, wc = wid & 3, fr = lane & 15, fq = lane >> 4;
    const int K = g.K, nt = K / BK;
    unsigned voffA[2], voffB[2];
#pragma unroll
    for (int i = 0; i < 2; ++i) { int R, C; stage_rc(tid * 16 + i * 8192, R, C); const int Rb = Epi::PERM ? ((R & ~31) + perm32(R & 31)) : R;
        voffA[i] = (unsigned)(R * K + C) * 2u; voffB[i] = (unsigned)(Rb * K + C) * 2u; }
    const size_t kstep = (size_t)(BK * 2);
    const size_t hstep = (size_t)HALF * K * 2;
    const size_t tstep = 2 * hstep;
    const unsigned ldsw = (unsigned)wid * 1024u;
    const int aoff = lds_byte(wr * 64 + fr, fq * 8), boff = lds_byte(wc * 32 + fr, fq * 8);
#define PG8_SA(b, h) (((b) * 2 + (h)) * HTB)
#define PG8_SB(b, h) ((4 + (b) * 2 + (h)) * HTB)
#define PG8_STAGE(bufoff, gbase, voff) do { _Pragma("unroll") for (int _i = 0; _i < 2; ++_i) \
        __builtin_amdgcn_global_load_lds((const unsigned*)((const char*)(gbase) + (voff)[_i]), (PG8_LAS unsigned*)(lds + (bufoff) + ldsw + _i * 8192), 16, 0, 0); } while (0)
#define PG8_LDA(dst, b, h) do { _Pragma("unroll") for (int m = 0; m < 4; ++m) _Pragma("unroll") for (int k = 0; k < 2; ++k) dst[m][k] = *(const PG8_LAS bf16x8*)(lds + PG8_SA(b, h) + aoff + m * 2048 + k * 1024); } while (0)
#define PG8_LDB(dst, b, h) do { _Pragma("unroll") for (int n = 0; n < 2; ++n) _Pragma("unroll") for (int k = 0; k < 2; ++k) dst[n][k] = *(const PG8_LAS bf16x8*)(lds + PG8_SB(b, h) + boff + n * 2048 + k * 1024); } while (0)
#define PG8_MMA(ai, bj, At, Bt) do { __builtin_amdgcn_s_setprio(1); _Pragma("unroll") for (int m = 0; m < 4; ++m) _Pragma("unroll") for (int n = 0; n < 2; ++n) _Pragma("unroll") for (int k = 0; k < 2; ++k) \
        acc[ai][bj][m][n] = __builtin_amdgcn_mfma_f32_16x16x32_bf16(Bt[n][k], At[m][k], acc[ai][bj][m][n], 0, 0, 0); __builtin_amdgcn_s_setprio(0); } while (0)
#define PG8_WAIT_V(n) asm volatile("s_waitcnt vmcnt(" #n ")" ::: "memory")
#define PG8_WAIT_L(n) asm volatile("s_waitcnt lgkmcnt(" #n ")" ::: "memory")
#define PG8_BAR __builtin_amdgcn_s_barrier()
#define PG8_SCHED __builtin_amdgcn_sched_barrier(0)
    Unit cur, nxt; int ui = 0;
    if (!S.next(0, cur)) return;
    f32x4 acc[2][2][4][2];
#pragma unroll
    for (int a = 0; a < 2; ++a)
#pragma unroll
        for (int b = 0; b < 2; ++b)
#pragma unroll
            for (int m = 0; m < 4; ++m)
#pragma unroll
                for (int n = 0; n < 2; ++n) acc[a][b][m][n] = (f32x4){0.f, 0.f, 0.f, 0.f};
    bf16x8 At[4][2], B0[2][2], B1[2][2];
    const char* cA = (const char*)g.A + (size_t)cur.pm * tstep; const char* cB = (const char*)g.Bt + (size_t)cur.pn * tstep;
    S.a_ready(cur);
    if constexpr (SP2) {
        PG8_STAGE(PG8_SB(0, 0), cB, voffB); PG8_STAGE(PG8_SB(0, 1), cB + hstep, voffB); PG8_STAGE(PG8_SA(0, 0), cA, voffA); PG8_STAGE(PG8_SA(0, 1), cA + hstep, voffA);
        if (wr == 1) PG8_BAR;
        PG8_WAIT_V(2); PG8_BAR;
        PG8_STAGE(PG8_SB(1, 0), cB + kstep, voffB); PG8_STAGE(PG8_SA(1, 0), cA + kstep, voffA); PG8_STAGE(PG8_SB(1, 1), cB + hstep + kstep, voffB);
        PG8_WAIT_V(6); PG8_BAR;
    } else {
        PG8_STAGE(PG8_SB(0, 0), cB, voffB); PG8_STAGE(PG8_SA(0, 0), cA, voffA); PG8_STAGE(PG8_SB(0, 1), cB + hstep, voffB); PG8_STAGE(PG8_SA(0, 1), cA + hstep, voffA);
        if (wr == 1) PG8_BAR;
        PG8_WAIT_V(4); PG8_BAR;
        PG8_STAGE(PG8_SB(1, 0), cB + kstep, voffB); PG8_STAGE(PG8_SA(1, 0), cA + kstep, voffA); PG8_STAGE(PG8_SB(1, 1), cB + hstep + kstep, voffB);
        PG8_WAIT_V(6); PG8_BAR;
    }
    for (;;) {
        const bool has_next = S.next(ui + 1, nxt);
        const char* nA = has_next ? (const char*)g.A + (size_t)nxt.pm * tstep : cA; const char* nB = has_next ? (const char*)g.Bt + (size_t)nxt.pn * tstep : cB;
        for (int t = 0; t < nt; t += 2) {
            const bool last = (t == nt - 2);
            const char* a1 = cA + (size_t)(t + 1) * kstep;
            const char* a2 = last ? nA : cA + (size_t)(t + 2) * kstep; const char* b2 = last ? nB : cB + (size_t)(t + 2) * kstep;
            const char* a3 = a2 + kstep; const char* b3 = b2 + kstep;
            if (last && has_next) S.a_ready(nxt);
            if constexpr (SP2) {
            PG8_LDB(B0, 0, 0); PG8_LDB(B1, 0, 1); PG8_SCHED; PG8_LDA(At, 0, 0); PG8_STAGE(PG8_SA(1, 1), a1 + hstep, voffA);
            PG8_WAIT_V(8); PG8_WAIT_L(0); PG8_BAR; PG8_MMA(0, 0, At, B0); PG8_MMA(0, 1, At, B1); PG8_BAR; PG8_SCHED;
            PG8_LDA(At, 0, 1); PG8_STAGE(PG8_SB(0, 0), b2, voffB); PG8_STAGE(PG8_SB(0, 1), b2 + hstep, voffB); PG8_STAGE(PG8_SA(0, 0), a2, voffA);
            PG8_WAIT_V(8); PG8_WAIT_L(0); PG8_BAR; PG8_MMA(1, 0, At, B0); PG8_MMA(1, 1, At, B1); PG8_BAR; PG8_SCHED;
            PG8_LDB(B0, 1, 0); PG8_LDB(B1, 1, 1); PG8_SCHED; PG8_LDA(At, 1, 0); PG8_STAGE(PG8_SA(0, 1), a2 + hstep, voffA);
            PG8_WAIT_V(8); PG8_WAIT_L(0); PG8_BAR; PG8_MMA(0, 0, At, B0); PG8_MMA(0, 1, At, B1); PG8_BAR; PG8_SCHED;
            PG8_LDA(At, 1, 1); PG8_STAGE(PG8_SB(1, 0), b3, voffB); PG8_STAGE(PG8_SB(1, 1), b3 + hstep, voffB); PG8_STAGE(PG8_SA(1, 0), a3, voffA);
            PG8_WAIT_V(8); PG8_WAIT_L(0); PG8_BAR; PG8_MMA(1, 0, At, B0); PG8_MMA(1, 1, At, B1); PG8_BAR; PG8_SCHED;
            } else {
            PG8_LDB(B0, 0, 0); PG8_SCHED; PG8_LDA(At, 0, 0); PG8_STAGE(PG8_SA(1, 1), a1 + hstep, voffA);
            PG8_WAIT_L(8); PG8_BAR; PG8_WAIT_L(0); PG8_MMA(0, 0, At, B0); PG8_BAR; PG8_SCHED;
            PG8_LDB(B1, 0, 1); PG8_STAGE(PG8_SB(0, 0), b2, voffB);
            PG8_BAR; PG8_WAIT_L(0); PG8_MMA(0, 1, At, B1); PG8_BAR;
            PG8_LDA(At, 0, 1); PG8_STAGE(PG8_SA(0, 0), a2, voffA);
            PG8_BAR; PG8_WAIT_L(0); PG8_MMA(1, 0, At, B0); PG8_BAR; PG8_SCHED;
            PG8_STAGE(PG8_SB(0, 1), b2 + hstep, voffB);
            PG8_WAIT_V(6); PG8_BAR; PG8_MMA(1, 1, At, B1); PG8_BAR;
            PG8_LDB(B0, 1, 0); PG8_SCHED; PG8_LDA(At, 1, 0); PG8_STAGE(PG8_SA(0, 1), a2 + hstep, voffA);
            PG8_WAIT_L(8); PG8_BAR; PG8_WAIT_L(0); PG8_MMA(0, 0, At, B0); PG8_BAR; PG8_SCHED;
            PG8_LDB(B1, 1, 1); PG8_STAGE(PG8_SB(1, 0), b3, voffB);
            PG8_BAR; PG8_WAIT_L(0); PG8_MMA(0, 1, At, B1); PG8_BAR;
            PG8_LDA(At, 1, 1); PG8_STAGE(PG8_SA(1, 0), a3, voffA);
            PG8_BAR; PG8_WAIT_L(0); PG8_MMA(1, 0, At, B0); PG8_BAR; PG8_SCHED;
            PG8_STAGE(PG8_SB(1, 1), b3 + hstep, voffB);
            PG8_WAIT_V(6); PG8_BAR; PG8_MMA(1, 1, At, B1); PG8_BAR;
            }
        }
        if constexpr (ALIGN_EPI) { if (wr == 0) PG8_BAR; }
        if constexpr (!Epi::AFTER_DRAIN) { E(acc, cur, wr, wc, fr, fq); S.done(cur); }
        if (!has_next) break;
#pragma unroll
        for (int a = 0; a < 2; ++a)
#pragma unroll
            for (int b = 0; b < 2; ++b)
#pragma unroll
                for (int m = 0; m < 4; ++m)
#pragma unroll
                    for (int n = 0; n < 2; ++n) acc[a][b][m][n] = (f32x4){0.f, 0.f, 0.f, 0.f};
        cur = nxt; cA = nA; cB = nB; ++ui;
        if constexpr (ALIGN_EPI) { if (wr == 1) PG8_BAR; }
    }
    PG8_WAIT_V(0);
    if constexpr (!ALIGN_EPI) { if (wr == 0) PG8_BAR; }
    PG8_BAR;
    if constexpr (Epi::AFTER_DRAIN) { E.fused(acc, cur, wr, wc, fr, fq, lds, wid, lane); S.done(cur); }
#undef PG8_SA
#undef PG8_SB
#undef PG8_STAGE
#undef PG8_LDA
#undef PG8_LDB
#undef PG8_MMA
#undef PG8_WAIT_V
#undef PG8_WAIT_L
#undef PG8_BAR
#undef PG8_SCHED
}
}

namespace pg8 {
struct EpiStore {
    static constexpr bool PERM = true, AFTER_DRAIN = false;
    bf16_t* O; int ldc; int ncols; int shift_from, shift;
    __device__ __forceinline__ void operator()(const f32x4 (&acc)[2][2][4][2], const Unit& u, int wr, int wc, int fr, int fq) const {
        const int row0 = u.pm * BM + wr * 64 + fr; const int col0 = u.pn * BM + wc * 32 + 8 * fq;
#pragma unroll
        for (int ai = 0; ai < 2; ++ai)
#pragma unroll
            for (int m = 0; m < 4; ++m) { bf16_t* rowp = O + (size_t)(row0 + ai * HALF + m * 16) * ldc;
#pragma unroll
                for (int bj = 0; bj < 2; ++bj) { const int col = col0 + bj * HALF;
                    if (col < ncols) { const f32x4 v0 = acc[ai][bj][m][0], v1 = acc[ai][bj][m][1];
                        u32x4 w; w.x = cvt_pk_bf16(v0[0], v0[1]); w.y = cvt_pk_bf16(v0[2], v0[3]); w.z = cvt_pk_bf16(v1[0], v1[1]); w.w = cvt_pk_bf16(v1[2], v1[3]);
                        *(u32x4*)(rowp + col + (col >= shift_from ? shift : 0)) = w; } } }
    }
};
struct EpiSwiGLU {
    static constexpr bool PERM = true, AFTER_DRAIN = false;
    bf16_t* O; int ldc;
    __device__ __forceinline__ void operator()(const f32x4 (&acc)[2][2][4][2], const Unit& u, int wr, int wc, int fr, int fq) const {
        const int row0 = u.pm * BM + wr * 64 + fr; const int col0 = u.pn * BM + wc * 32 + 8 * fq;
#pragma unroll
        for (int ai = 0; ai < 2; ++ai)
#pragma unroll
            for (int m = 0; m < 4; ++m) { bf16_t* rowp = O + (size_t)(row0 + ai * HALF + m * 16) * ldc;
#pragma unroll
                for (int bj = 0; bj < 2; ++bj) { const int col = col0 + bj * HALF; const f32x4 g = acc[ai][bj][m][0], up = acc[ai][bj][m][1];
                    float r[4];
#pragma unroll
                    for (int i = 0; i < 4; ++i) r[i] = g[i] * __builtin_amdgcn_rcpf(1.f + __expf(-g[i])) * up[i];
                    uint2 w; w.x = cvt_pk_bf16(r[0], r[1]); w.y = cvt_pk_bf16(r[2], r[3]);
                    *(uint2*)(rowp + (col >> 1)) = w; } }
    }
};

struct PanelStats {
    unsigned* xbuf;
    unsigned* cnt;
    unsigned* tmo;
    int ntn; float eps;
    unsigned code;
    __device__ __forceinline__ bool run(const f32x4 (&v)[2][2][4][2], const Unit& u, int wr, int wc, int fr, int fq, PG8_LAS unsigned char* lds, int wid, int lane) const {
        typedef float f32x2v __attribute__((ext_vector_type(2)));
        PG8_LAS f32x2v* P = (PG8_LAS f32x2v*)lds;
        PG8_LAS f32x2v* S = (PG8_LAS f32x2v*)(lds + 8192);
        PG8_LAS unsigned* flag = (PG8_LAS unsigned*)(lds + 8192 + 2048);
#pragma unroll
        for (int ai = 0; ai < 2; ++ai)
#pragma unroll
            for (int m = 0; m < 4; ++m) {
                float s = 0.f;
#pragma unroll
                for (int bj = 0; bj < 2; ++bj)
#pragma unroll
                    for (int n = 0; n < 2; ++n) { const f32x4 x = v[ai][bj][m][n]; s += (x[0] + x[1]) + (x[2] + x[3]); }
                s += __shfl_xor(s, 16); s += __shfl_xor(s, 32);
                const float mw = s * (1.0f / 64.0f); float q = 0.f;
#pragma unroll
                for (int bj = 0; bj < 2; ++bj)
#pragma unroll
                    for (int n = 0; n < 2; ++n) { const f32x4 d = v[ai][bj][m][n] - mw; q += (d[0] * d[0] + d[1] * d[1]) + (d[2] * d[2] + d[3] * d[3]); }
                q += __shfl_xor(q, 16); q += __shfl_xor(q, 32);
                if (fq == 0) P[(ai * HALF + wr * 64 + m * 16 + fr) * 4 + wc] = (f32x2v){mw, q};
            }
        asm volatile("s_waitcnt lgkmcnt(0)" ::: "memory"); __builtin_amdgcn_s_barrier(); asm volatile("" ::: "memory");
        const int row = wid * 32 + (lane & 31);
        if (lane < 32) {
            const f32x2v a = P[row * 4 + 0], b = P[row * 4 + 1], c = P[row * 4 + 2], d = P[row * 4 + 3];
            const float mt = (a.x + b.x + c.x + d.x) * 0.25f;
            const float da = a.x - mt, db = b.x - mt, dc = c.x - mt, dd = d.x - mt;
            const float m2 = (a.y + b.y) + (c.y + d.y) + 64.0f * ((da * da + db * db) + (dc * dc + dd * dd));
            unsigned long long* slot = (unsigned long long*)xbuf + ((size_t)(u.pm * BM + row) * 4 + u.pn);
            __hip_atomic_store(slot, ((unsigned long long)__float_as_uint(m2) << 32) | __float_as_uint(mt), __ATOMIC_RELAXED, __HIP_MEMORY_SCOPE_AGENT);
        }
        asm volatile("s_waitcnt vmcnt(0)" ::: "memory");
        if (lane == 0) __hip_atomic_fetch_add(cnt + 64 * u.pm, 1u, __ATOMIC_RELAXED, __HIP_MEMORY_SCOPE_AGENT);
        if (wid == 0) {
            bool dead = false; const unsigned long long t0 = __builtin_amdgcn_s_memrealtime(); const unsigned want = 8u * (unsigned)ntn;
            for (;;) {
                if ((unsigned)__builtin_amdgcn_readfirstlane(__hip_atomic_load(cnt + 64 * u.pm, __ATOMIC_RELAXED, __HIP_MEMORY_SCOPE_AGENT)) >= want) break;
                if (__builtin_amdgcn_s_memrealtime() - t0 > 2000000ull) {
                    if (lane == 0) { unsigned expect = 0u; __hip_atomic_compare_exchange_strong(tmo + 1, &expect, code | (unsigned)(u.pm & 0xff), __ATOMIC_RELAXED, __ATOMIC_RELAXED, __HIP_MEMORY_SCOPE_AGENT);
                                     __hip_atomic_store(tmo, 1u, __ATOMIC_RELAXED, __HIP_MEMORY_SCOPE_AGENT); }
                    dead = true; break; }
                __builtin_amdgcn_s_sleep(2);
            }
            __builtin_amdgcn_fence(__ATOMIC_ACQUIRE, "agent");
            if (lane == 0) flag[0] = dead ? 1u : 0u;
        }
        asm volatile("s_waitcnt vmcnt(0) lgkmcnt(0)" ::: "memory"); __builtin_amdgcn_s_barrier(); asm volatile("" ::: "memory");
        const bool bad = flag[0] != 0u;
        if (lane < 32) {
            const unsigned long long* slot = (const unsigned long long*)xbuf + (size_t)(u.pm * BM + row) * 4; float mt[4], m2[4]; float ms = 0.f;
#pragma unroll
            for (int t = 0; t < 4; ++t) { if (t < ntn) { const unsigned long long w = __hip_atomic_load(slot + t, __ATOMIC_RELAXED, __HIP_MEMORY_SCOPE_AGENT); mt[t] = __uint_as_float((unsigned)w); m2[t] = __uint_as_float((unsigned)(w >> 32)); } else { mt[t] = 0.f; m2[t] = 0.f; } ms += mt[t]; }
            const float mean = ms / (float)ntn; float q = 0.f;
#pragma unroll
            for (int t = 0; t < 4; ++t) if (t < ntn) { const float dm = mt[t] - mean; q += m2[t] + 256.0f * dm * dm; }
            S[row] = (f32x2v){mean, 1.0f / sqrtf(q / (256.0f * (float)ntn) + mean * mean + eps)};
        }
        asm volatile("s_waitcnt lgkmcnt(0)" ::: "memory"); __builtin_amdgcn_s_barrier(); asm volatile("" ::: "memory");
        return bad;
    }
};

struct EpiRms2 {
    static constexpr bool PERM = true, AFTER_DRAIN = true;
    const float* base; float* out; bf16_t* xn; int ldc; const float* g1; const float* g2; PanelStats st1, st2;
    __device__ __forceinline__ void fused(f32x4 (&acc)[2][2][4][2], const Unit& u, int wr, int wc, int fr, int fq, PG8_LAS unsigned char* lds, int wid, int lane) const {
        typedef float f32x2v __attribute__((ext_vector_type(2)));
        const PG8_LAS f32x2v* S = (const PG8_LAS f32x2v*)(lds + 8192);
        const int col0 = u.pn * BM + wc * 32 + 8 * fq;
        bool bad = st1.run(acc, u, wr, wc, fr, fq, lds, wid, lane);
        const float qnan = __builtin_nanf("");
#pragma unroll
        for (int ai = 0; ai < 2; ++ai)
#pragma unroll
            for (int m = 0; m < 4; ++m) { const int r = ai * HALF + wr * 64 + m * 16 + fr; const f32x2v sr = S[r]; const size_t off = (size_t)(u.pm * BM + r) * ldc + col0;
#pragma unroll
                for (int bj = 0; bj < 2; ++bj)
#pragma unroll
                    for (int n = 0; n < 2; ++n) { const f32x4 bs = *(const f32x4*)(base + off + bj * HALF + n * 4); const f32x4 gv = *(const f32x4*)(g1 + col0 + bj * HALF + n * 4);
                        acc[ai][bj][m][n] = bs + acc[ai][bj][m][n] * sr.y * gv; }
                asm volatile("" : "+v"(acc[ai][0][m][0]), "+v"(acc[ai][0][m][1]), "+v"(acc[ai][1][m][0]), "+v"(acc[ai][1][m][1]));
                if (m & 1) asm volatile("" ::: "memory"); }
        const bool bad1 = bad;
        bad = st2.run(acc, u, wr, wc, fr, fq, lds, wid, lane) || bad;
#pragma unroll
        for (int ai = 0; ai < 2; ++ai)
#pragma unroll
            for (int m = 0; m < 4; ++m) { const int r = ai * HALF + wr * 64 + m * 16 + fr; const f32x2v sr = S[r]; const size_t off = (size_t)(u.pm * BM + r) * ldc + col0;
#pragma unroll
                for (int bj = 0; bj < 2; ++bj) { u32x4 w;
#pragma unroll
                    for (int n = 0; n < 2; ++n) { const f32x4 x1 = acc[ai][bj][m][n]; *(f32x4*)(out + off + bj * HALF + n * 4) = bad1 ? (f32x4){qnan, qnan, qnan, qnan} : x1;
                        const f32x4 gv = *(const f32x4*)(g2 + col0 + bj * HALF + n * 4);
                        const f32x4 o = x1 * sr.y * gv; if (n == 0) { w.x = cvt_pk_bf16(o[0], o[1]); w.y = cvt_pk_bf16(o[2], o[3]); } else { w.z = cvt_pk_bf16(o[0], o[1]); w.w = cvt_pk_bf16(o[2], o[3]); } }
                    if (bad) { w.x = 0x7fc07fc0u; w.y = 0x7fc07fc0u; w.z = 0x7fc07fc0u; w.w = 0x7fc07fc0u; }
                    *(u32x4*)(xn + off + bj * HALF) = w; }
                asm volatile("" ::: "memory"); }
    }
};
}

constexpr int L_SEQ = 8192, NB = 2, MTOK = NB * L_SEQ, DM = 1024, DIN = 3104, DIN_PAD = 3328, DFF = 2816, DEPTH = 4;
constexpr int C_QA = 0, C_KA = 256, C_VA = 512, C_GA = 768, C_ZA = 1024, C_QB = 1056, C_XC = 1824, C_GC = 2080, C_QD = 2336;
constexpr float EPS = 1e-6f;
#define FUSE_NORM 0
#define ZSPLIT 1
constexpr size_t A256(size_t x) { return (x + 255) & ~(size_t)255; }
constexpr size_t WS_CTL = 0, CTL_SEAM = 65536, CTL_TMO = 32768, CTL_BYTES = FUSE_NORM ? 65536 + 16 * 16384 : 65536;
constexpr size_t WS_ROPE = CTL_BYTES;
constexpr size_t WS_LRUW = WS_ROPE + A256((size_t)L_SEQ * 32 * 8);
constexpr size_t WS_WIN  = WS_LRUW + A256((size_t)DEPTH * 2 * 2 * 4 * 4096 * 2);
constexpr size_t WS_WOUT = WS_WIN + (size_t)DEPTH * DIN_PAD * DM * 2;
constexpr size_t WS_WF1  = WS_WOUT + (size_t)DEPTH * DM * DM * 2;
constexpr size_t WS_WF2  = WS_WF1 + (size_t)DEPTH * 2 * DFF * DM * 2;
constexpr size_t WS_H    = WS_WF2 + (size_t)DEPTH * DM * DFF * 2;
constexpr size_t WS_P    = WS_H + (size_t)MTOK * DM * 2;
constexpr size_t WS_GLA  = WS_P + (size_t)MTOK * DIN * 2;
constexpr size_t WS_GDEC = WS_GLA + (size_t)2048 * 4096 * 4;
constexpr size_t WS_LRUA = WS_GDEC + (size_t)2048 * 64 * 4;
constexpr size_t WS_LRUH = WS_LRUA + (size_t)2 * 2 * 128 * 256 * 4;
constexpr size_t WS_DAP  = WS_LRUH + (size_t)2 * 2 * 128 * 256 * 4;
constexpr size_t WS_DAL  = WS_DAP + (size_t)3 * MTOK * 256 * 2;
constexpr size_t WS_GB   = WS_DAL + (size_t)3 * MTOK * 4 * 4;
constexpr size_t WS_XB   = WS_GB + (size_t)2048 * 4096 * 4;
constexpr size_t WS_END  = WS_XB + 2 * 524288;

constexpr int LDS_BYTES = 147456;
constexpr int NTHR = 512;

typedef unsigned short u16;
typedef short bf16x8 __attribute__((ext_vector_type(8)));
typedef float f32x4 __attribute__((ext_vector_type(4)));
typedef unsigned u32x4 __attribute__((ext_vector_type(4)));

struct Params { const float* in[20]; float* out; unsigned char* ws; int ph_lo, ph_hi; };
typedef const Params __attribute__((address_space(4)))* PP;
__device__ __forceinline__ PP get_pp() { PP p = (PP)__builtin_amdgcn_kernarg_segment_ptr(); asm volatile("" : "+s"(p)); return p; }

__device__ __forceinline__ unsigned f2bf(float f) { unsigned u = __float_as_uint(f); return (u + 0x7fffu + ((u >> 16) & 1u)) >> 16; }
__device__ __forceinline__ float bf2f(unsigned h) { return __uint_as_float(h << 16); }
__device__ __forceinline__ unsigned pk2(float lo, float hi) { return f2bf(lo) | (f2bf(hi) << 16); }
__device__ __forceinline__ float blo(unsigned w) { return __uint_as_float(w << 16); }
__device__ __forceinline__ float bhi(unsigned w) { return __uint_as_float(w & 0xffff0000u); }
#define UNPACK8(v, f) do { f[0] = blo(v.x); f[1] = bhi(v.x); f[2] = blo(v.y); f[3] = bhi(v.y); f[4] = blo(v.z); f[5] = bhi(v.z); f[6] = blo(v.w); f[7] = bhi(v.w); } while (0)
__device__ __forceinline__ unsigned cvtpk(float lo, float hi) { unsigned r; asm("v_cvt_pk_bf16_f32 %0, %1, %2" : "=v"(r) : "v"(lo), "v"(hi)); return r; }
#define PACK8(v, f) do { v.x = cvtpk(f[0], f[1]); v.y = cvtpk(f[2], f[3]); v.z = cvtpk(f[4], f[5]); v.w = cvtpk(f[6], f[7]); } while (0)
__device__ __forceinline__ f32x4 mfma16(bf16x8 a, bf16x8 b, f32x4 c) { return __builtin_amdgcn_mfma_f32_16x16x32_bf16(a, b, c, 0, 0, 0); }
__device__ __forceinline__ bf16x8 ldfrag(const u16* p) { return *(const bf16x8*)p; }
__device__ __forceinline__ float wave_sum(float v) {
#pragma unroll
    for (int o = 1; o < 64; o <<= 1) v += __shfl_xor(v, o);
    return v;
}
__device__ __forceinline__ float rcpf_(float x) { return __builtin_amdgcn_rcpf(x); }
__device__ __forceinline__ float sigmoidf_(float x) { return rcpf_(1.f + __expf(-x)); }
__device__ __forceinline__ float softplusf_(float x) { return fmaxf(x, 0.f) + __logf(1.f + __expf(-fabsf(x))); }
__device__ __forceinline__ float logsigmoidf_(float x) { return -softplusf_(-x); }
__device__ __forceinline__ float gelu_tanh(float x) { const float u = 0.7978845608028654f * (x + 0.044715f * x * x * x); return x * sigmoidf_(2.f * u); }

constexpr int LP = 72;
constexpr int FP = 65;

template <int MODE>
__device__ __forceinline__ void conv_weight(const float* __restrict__ W, int K, int N, int Npad, u16* __restrict__ WT, float* scr, int it, int lane) {
    const int nblk = Npad / 64;
    const int kr = lane >> 4, nc = lane & 15;
    {
        const int nb = it % nblk, kb = it / nblk;
        int col;
        if (MODE == 0) { col = nb * 64 + 4 * nc; if (col >= N) col = -1; }
        else if (MODE == 1) col = (nc < 8) ? nb * 32 + 4 * nc : DFF + nb * 32 + 4 * (nc - 8);
        else { const int r = nb * 64 + 4 * nc; col = (r < 1024) ? r : (r < 3072 ? r + 32 : (r < 3104 ? r - 2048 : -1)); }
        f32x4 v[16];
#pragma unroll
        for (int i = 0; i < 16; ++i) v[i] = (col >= 0) ? __builtin_nontemporal_load((const f32x4*)(W + (size_t)(kb * 64 + 4 * i + kr) * N + col)) : (f32x4){0.f, 0.f, 0.f, 0.f};
#pragma unroll
        for (int i = 0; i < 16; ++i) { float* s = scr + (4 * i + kr) * 65 + 4 * nc; s[0] = v[i].x; s[1] = v[i].y; s[2] = v[i].z; s[3] = v[i].w; }
        asm volatile("s_waitcnt lgkmcnt(0)" ::: "memory");
        int sc = lane;
        if (MODE == 1) { const int blk = lane >> 3, w = lane & 7; sc = (w < 4) ? blk * 4 + w : 32 + blk * 4 + (w - 4); }
        u16* dst = WT + (size_t)(nb * 64 + lane) * K + kb * 64;
#pragma unroll
        for (int kc = 0; kc < 8; ++kc) { float f[8];
#pragma unroll
            for (int j2 = 0; j2 < 8; ++j2) f[j2] = scr[(kc * 8 + j2) * 65 + sc];
            u32x4 o; PACK8(o, f); *(u32x4*)(dst + kc * 8) = o; }
        asm volatile("s_waitcnt lgkmcnt(0)" ::: "memory");
    }
}

__device__ __forceinline__ void row_pass(int mode, const float* xin, float* xout, const u16* yo, const float* g_post, const float* g_next, u16* hout, int gw, int ngw, int lane) {
    for (int row0 = gw; row0 < MTOK; row0 += 2 * ngw) {
        const int rows[2] = {row0, row0 + ngw}; const bool has1 = (row0 + ngw) < MTOK;
        f32x4 xv[2][4]; uint2 yw[2][4];
#pragma unroll
        for (int q = 0; q < 2; ++q) { const int row = (q == 0 || has1) ? rows[q] : row0;
#pragma unroll
            for (int j = 0; j < 4; ++j) { xv[q][j] = __builtin_nontemporal_load((const f32x4*)(xin + (size_t)row * DM + 4 * lane + 256 * j));
                if (mode == 1) { const unsigned long long t_ = __builtin_nontemporal_load((const unsigned long long*)(yo + (size_t)row * DM + 4 * lane + 256 * j)); yw[q][j] = make_uint2((unsigned)t_, (unsigned)(t_ >> 32)); } } }
        if (mode == 1) {
            float ss[2] = {0.f, 0.f}; f32x4 yv[2][4];
#pragma unroll
            for (int q = 0; q < 2; ++q)
#pragma unroll
                for (int j = 0; j < 4; ++j) { yv[q][j] = (f32x4){blo(yw[q][j].x), bhi(yw[q][j].x), blo(yw[q][j].y), bhi(yw[q][j].y)};
                    ss[q] += yv[q][j].x * yv[q][j].x + yv[q][j].y * yv[q][j].y + yv[q][j].z * yv[q][j].z + yv[q][j].w * yv[q][j].w; }
#pragma unroll
            for (int o = 1; o < 64; o <<= 1) { ss[0] += __shfl_xor(ss[0], o); ss[1] += __shfl_xor(ss[1], o); }
#pragma unroll
            for (int j = 0; j < 4; ++j) { const f32x4 g = *(const f32x4*)(g_post + 4 * lane + 256 * j);
#pragma unroll
                for (int q = 0; q < 2; ++q) { const float rs = rsqrtf(ss[q] * (1.f / DM) + EPS); xv[q][j] = xv[q][j] + yv[q][j] * rs * g;
                    if (q == 0 || has1) __builtin_nontemporal_store(xv[q][j], (f32x4*)(xout + (size_t)rows[q] * DM + 4 * lane + 256 * j)); } }
        }
        if (g_next) {
            float ss[2] = {0.f, 0.f};
#pragma unroll
            for (int q = 0; q < 2; ++q)
#pragma unroll
                for (int j = 0; j < 4; ++j) ss[q] += xv[q][j].x * xv[q][j].x + xv[q][j].y * xv[q][j].y + xv[q][j].z * xv[q][j].z + xv[q][j].w * xv[q][j].w;
#pragma unroll
            for (int o = 1; o < 64; o <<= 1) { ss[0] += __shfl_xor(ss[0], o); ss[1] += __shfl_xor(ss[1], o); }
#pragma unroll
            for (int j = 0; j < 4; ++j) { const f32x4 g = *(const f32x4*)(g_next + 4 * lane + 256 * j);
#pragma unroll
                for (int q = 0; q < 2; ++q) { const float rs = rsqrtf(ss[q] * (1.f / DM) + EPS); const f32x4 v = xv[q][j] * rs * g;
                    uint2 w; w.x = cvtpk(v.x, v.y); w.y = cvtpk(v.z, v.w);
                    if (q == 0 || has1) *(uint2*)(hout + (size_t)rows[q] * DM + 4 * lane + 256 * j) = w; } }
        }
    }
}

__device__ __forceinline__ void prologue(int tid, int lane, int wave, int bid, int G, unsigned char* lds) {
    PP pp = get_pp();
    float* scr = (float*)(lds + wave * (64 * 65 * 4));
    unsigned char* ws = pp->ws;
    const int gw = bid * 8 + wave, ngw = G * 8;
    const int gt = bid * NTHR + tid, ngt = G * NTHR;
    constexpr int I_IN = (DIN_PAD / 64) * (DM / 64), I_OUT = (DM / 64) * (DM / 64), I_F1 = (2 * DFF / 64) * (DM / 64), I_F2 = (DM / 64) * (DFF / 64);
    for (int l = 0; l < DEPTH; ++l) {
        const int o0 = (l * (I_IN + I_OUT + I_F1 + I_F2)) % ngw, o1 = (o0 + I_IN) % ngw, o2 = (o1 + I_OUT) % ngw, o3 = (o2 + I_F1) % ngw;
        for (int r = (gw + ngw - o0) % ngw; r < I_IN; r += ngw) conv_weight<ZSPLIT ? 2 : 0>(pp->in[3] + (size_t)l * DM * DIN, DM, DIN, DIN_PAD, (u16*)(ws + WS_WIN) + (size_t)l * DIN_PAD * DM, scr, r, lane);
        for (int r = (gw + ngw - o1) % ngw; r < I_OUT; r += ngw) conv_weight<0>(pp->in[15] + (size_t)l * DM * DM, DM, DM, DM, (u16*)(ws + WS_WOUT) + (size_t)l * DM * DM, scr, r, lane);
        for (int r = (gw + ngw - o2) % ngw; r < I_F1; r += ngw) conv_weight<1>(pp->in[18] + (size_t)l * DM * 2 * DFF, DM, 2 * DFF, 2 * DFF, (u16*)(ws + WS_WF1) + (size_t)l * 2 * DFF * DM, scr, r, lane);
        for (int r = (gw + ngw - o3) % ngw; r < I_F2; r += ngw) conv_weight<0>(pp->in[19] + (size_t)l * DFF * DM, DFF, DM, DM, (u16*)(ws + WS_WF2) + (size_t)l * DM * DFF, scr, r, lane);
    }
    { u16* wt = (u16*)(ws + WS_LRUW);
      for (int idx = gt; idx < DEPTH * 2 * 2 * 4 * 4096; idx += ngt) {
          const int i = idx & 63, j = (idx >> 6) & 63, h = (idx >> 12) & 3, e = (idx >> 14) & 1, mat = (idx >> 15) & 1, l = idx >> 16;
          const float* W = mat ? pp->in[12] : pp->in[10];
          wt[idx] = (u16)f2bf(W[((((size_t)l * 2 + e) * 4 + h) * 64 + i) * 64 + j]); } }
    { float2* tab = (float2*)(ws + WS_ROPE);
      for (int idx = gt; idx < L_SEQ * 32; idx += ngt) { const int pos = idx >> 5, i = idx & 31;
          const float inv = powf(10000.f, -(float)(2 * i) / 64.f); const float ang = (float)pos * inv; float s, c; sincosf(ang, &s, &c); tab[idx] = make_float2(c, s); } }
    row_pass(0, pp->in[0], nullptr, nullptr, nullptr, pp->in[1], (u16*)(ws + WS_H), gw, ngw, lane);
}

constexpr int ATT_HALF_BYTES = 6 * 64 * LP * 2 + 2048;
__device__ __forceinline__ void rope8(u32x4& lo, u32x4& hi, const float2* tab) {
    float a[8], b[8], oa[8], ob[8]; UNPACK8(lo, a); UNPACK8(hi, b);
#pragma unroll
    for (int i = 0; i < 8; ++i) { const float2 cs = tab[i]; oa[i] = a[i] * cs.x - b[i] * cs.y; ob[i] = b[i] * cs.x + a[i] * cs.y; }
    PACK8(lo, oa); PACK8(hi, ob);
}
#define VT_SCATTER(dst, v) do { (dst)[0 * LP] = (u16)((v).x & 0xffff); (dst)[1 * LP] = (u16)((v).x >> 16); (dst)[2 * LP] = (u16)((v).y & 0xffff); (dst)[3 * LP] = (u16)((v).y >> 16); \
    (dst)[4 * LP] = (u16)((v).z & 0xffff); (dst)[5 * LP] = (u16)((v).z >> 16); (dst)[6 * LP] = (u16)((v).w & 0xffff); (dst)[7 * LP] = (u16)((v).w >> 16); } while (0)
template <int TYPE>
__device__ __forceinline__ void attn_unit(int layer, int uidx, unsigned char* hl, int ht) {
    PP pp = get_pp();
    const int lane = ht & 63, hw = __builtin_amdgcn_readfirstlane(ht >> 6), fr = lane & 15, fq = lane >> 4;
    u16* Qs = (u16*)hl; u16* Ks = Qs + 2 * 64 * LP; float* Bs = (float*)(Ks + 4 * 64 * LP);
    u16* Ps = Qs;
    const u16* pbuf = (const u16*)(pp->ws + WS_P);
    const float2* rtab = (const float2*)(pp->ws + WS_ROPE);
    constexpr float LOG2E = 1.4426950408889634f;
    int b, h, r = 0, rsA = 0, rsB = 0, dil = 1, nb = 128, rho = 0, jb = 0, br = 0;
    if (TYPE == 0) { b = uidx >> 8; h = (uidx >> 6) & 3; r = 2 * (uidx & 63); rsA = min(max(r - 4, 0), 120); rsB = min(max(r - 3, 0), 120); }
    else { br = uidx >> 9; const int rem = uidx & 511; b = rem >> 8; h = (rem >> 6) & 3; const int w = rem & 63; dil = (br == 0) ? 1 : (br == 1 ? 4 : 16); nb = 128 / dil; const int nbp = nb >> 1; rho = w / nbp; jb = 2 * (w % nbp); }
    const int qstr = (TYPE == 0) ? 1 : dil;
    const int qtokA = (TYPE == 0) ? r * 64 : rho + dil * 64 * jb; const int qtokB = qtokA + 64 * qstr;
    const size_t rowbase = (size_t)b * L_SEQ;
    const int qcol = ((TYPE == 0) ? C_QB : C_QD) + h * 64;
    const int nkb = (TYPE == 0) ? 9 : 4;
    const int srow = ht >> 2, sc = ht & 3;
    const int vkp = ht >> 3, vdc = ht & 7;
#define KB_INFO(kb_, ktok0_, valid_) do { if (TYPE == 0) { const int kr_ = rsA + (kb_); valid_ = (kr_ <= rsB + 7); ktok0_ = kr_ * 64; } \
        else { const int kj_ = jb - 1 + (kb_); valid_ = (kj_ >= 0 && kj_ < nb); ktok0_ = rho + dil * 64 * kj_; } } while (0)
#define KV_PREFETCH(kt0_) do { const int tok_ = (kt0_) + qstr * srow; const u16* src_ = pbuf + (rowbase + tok_) * DIN + qcol + 256; \
        klo = *(const u32x4*)(src_ + 8 * sc); khi = *(const u32x4*)(src_ + 32 + 8 * sc); \
        if (TYPE == 1) { const f32x4* ct_ = (const f32x4*)(rtab + (size_t)tok_ * 32 + 8 * sc); pcs[0] = ct_[0]; pcs[1] = ct_[1]; pcs[2] = ct_[2]; pcs[3] = ct_[3]; } \
        const u16* vs_ = pbuf + (rowbase + (kt0_) + qstr * 2 * vkp) * DIN + qcol + 512 + 8 * vdc; va = *(const u32x4*)vs_; vb = *(const u32x4*)(vs_ + (size_t)qstr * DIN); } while (0)
    u32x4 klo, khi, va, vb; f32x4 pcs[4]; bool pvalid;
#define KV_STAGE(bufi_) do { u16* Kd_ = Ks + (bufi_) * (2 * 64 * LP); u16* Vd_ = Kd_ + 64 * LP; \
        if (TYPE == 1) { float a_[8], c_[8], oa_[8], ob_[8]; UNPACK8(klo, a_); UNPACK8(khi, c_); \
            _Pragma("unroll") for (int i_ = 0; i_ < 4; ++i_) { const f32x4 cs_ = pcs[i_]; \
                oa_[2 * i_] = a_[2 * i_] * cs_.x - c_[2 * i_] * cs_.y; ob_[2 * i_] = c_[2 * i_] * cs_.x + a_[2 * i_] * cs_.y; \
                oa_[2 * i_ + 1] = a_[2 * i_ + 1] * cs_.z - c_[2 * i_ + 1] * cs_.w; ob_[2 * i_ + 1] = c_[2 * i_ + 1] * cs_.z + a_[2 * i_ + 1] * cs_.w; } \
            PACK8(klo, oa_); PACK8(khi, ob_); } \
        *(u32x4*)(Kd_ + srow * LP + 8 * sc) = klo; *(u32x4*)(Kd_ + srow * LP + 32 + 8 * sc) = khi; \
        unsigned* vt_ = (unsigned*)(Vd_ + (8 * vdc) * LP + 2 * vkp); \
        vt_[0 * (LP / 2)] = (va.x & 0xffffu) | (vb.x << 16); vt_[1 * (LP / 2)] = (va.x >> 16) | (vb.x & 0xffff0000u); \
        vt_[2 * (LP / 2)] = (va.y & 0xffffu) | (vb.y << 16); vt_[3 * (LP / 2)] = (va.y >> 16) | (vb.y & 0xffff0000u); \
        vt_[4 * (LP / 2)] = (va.z & 0xffffu) | (vb.z << 16); vt_[5 * (LP / 2)] = (va.z >> 16) | (vb.z & 0xffff0000u); \
        vt_[6 * (LP / 2)] = (va.w & 0xffffu) | (vb.w << 16); vt_[7 * (LP / 2)] = (va.w >> 16) | (vb.w & 0xffff0000u); } while (0)
    { int kt0; KB_INFO(0, kt0, pvalid); if (pvalid) { KV_PREFETCH(kt0); } }
    __syncthreads();
#pragma unroll
    for (int tq = 0; tq < 2; ++tq) { const int tok = (tq ? qtokB : qtokA) + qstr * srow; const u16* src = pbuf + (rowbase + tok) * DIN + qcol;
      u32x4 lo = *(const u32x4*)(src + 8 * sc), hi = *(const u32x4*)(src + 32 + 8 * sc);
      if (TYPE == 1) rope8(lo, hi, rtab + (size_t)tok * 32 + 8 * sc);
      *(u32x4*)(Qs + (tq * 64 + srow) * LP + 8 * sc) = lo; *(u32x4*)(Qs + (tq * 64 + srow) * LP + 32 + 8 * sc) = hi; }
    if (TYPE == 0) { const float* rpb = pp->in[7] + (size_t)(layer * 4 + h) * 465; for (int i = ht; i < 465; i += 256) Bs[i] = rpb[i] * LOG2E; }
    bool cvalid = pvalid;
    if (pvalid) { KV_STAGE(0); }
    { int kt0; KB_INFO(1, kt0, pvalid); if (pvalid) { KV_PREFETCH(kt0); } }
    const int qi = 16 * hw + fr;
    unsigned okm = 0xffffu; int bofs[16];
#pragma unroll
    for (int n = 0; n < 4; ++n)
#pragma unroll
        for (int j = 0; j < 4; ++j) { const int kj = 16 * n + 4 * fq + j;
            if (TYPE == 0) { const int cs = min(max(qi - 8, 0), 48); if (!((kj >= cs) && (kj < cs + 16))) okm &= ~(1u << (4 * n + j)); bofs[4 * n + j] = min(max(kj - qi, -15), 15) + 15; }
            else bofs[4 * n + j] = 0; }
    f32x4 o[2][4]; float mrow[2], lrow[2];
#pragma unroll
    for (int tq = 0; tq < 2; ++tq) { mrow[tq] = -INFINITY; lrow[tq] = 0.f;
#pragma unroll
        for (int i = 0; i < 4; ++i) o[tq][i] = (f32x4){0.f, 0.f, 0.f, 0.f}; }
    __syncthreads();
    bf16x8 aq[2][2];
#pragma unroll
    for (int tq = 0; tq < 2; ++tq) { aq[tq][0] = ldfrag(Qs + (tq * 64 + qi) * LP + fq * 8); aq[tq][1] = ldfrag(Qs + (tq * 64 + qi) * LP + 32 + fq * 8); }
    asm volatile("s_waitcnt lgkmcnt(0)" ::: "memory");
    const bool stag = (ht != (int)threadIdx.x);
    bool nvalid = false;
#define STAGE_NEXT() do { if (kb + 1 < nkb) { if (pvalid) { KV_STAGE((kb + 1) & 1); } nvalid = pvalid; \
        if (kb + 2 < nkb) { int kt0_; KB_INFO(kb + 2, kt0_, pvalid); if (pvalid) { KV_PREFETCH(kt0_); } } } } while (0)
#pragma unroll 2
    for (int kb = 0; kb < nkb; ++kb) {
        const u16* Kc = Ks + (kb & 1) * (2 * 64 * LP); const u16* Vc = Kc + 64 * LP;
        if (stag) { STAGE_NEXT(); }
        if (cvalid) {
#pragma unroll
            for (int tq = 0; tq < 2; ++tq) {
                bool act; int delta = 0, dr = 0;
                if (TYPE == 0) { const int krow = rsA + kb; const int rq = r + tq; const int rsq = tq ? rsB : rsA; act = (krow >= rsq) && (krow <= rsq + 7); dr = krow - rq; }
                else { delta = kb - 1 - tq; act = (delta >= -1) && (delta <= 1); }
                int ntlo = 0, nthi = 3;
                if (TYPE == 0) { const int klo_ = min(max(16 * hw - 8, 0), 48), khi_ = min(max(16 * hw + 15 - 8, 0), 48) + 15; ntlo = klo_ >> 4; nthi = khi_ >> 4; }
                else { if (delta < 0) ntlo = hw; else if (delta > 0) nthi = hw; }
                if (act) {
                    float bsv[16];
#pragma unroll
                    for (int i = 0; i < 16; ++i) bsv[i] = (TYPE == 0) ? Bs[(dr + 7) * 31 + bofs[i]] : 0.f;
                    f32x4 s[4];
#pragma unroll
                    for (int n = 0; n < 4; ++n) { s[n] = (f32x4){0.f, 0.f, 0.f, 0.f};
                        if (n >= ntlo && n <= nthi) {
                            s[n] = mfma16(ldfrag(Kc + (16 * n + fr) * LP + fq * 8), aq[tq][0], s[n]);
                            s[n] = mfma16(ldfrag(Kc + (16 * n + fr) * LP + 32 + fq * 8), aq[tq][1], s[n]); } }
                    float mx = -INFINITY;
#pragma unroll
                    for (int n = 0; n < 4; ++n)
#pragma unroll
                        for (int j = 0; j < 4; ++j) { const int kj = 16 * n + 4 * fq + j; bool ok; float v = s[n][j] * (0.125f * LOG2E);
                            if (TYPE == 0) { ok = (okm >> (4 * n + j)) & 1u; v += bsv[4 * n + j]; }
                            else { ok = (delta == 0) ? true : (delta < 0 ? (kj >= qi) : (kj <= qi)); }
                            v = ok ? v : -INFINITY; s[n][j] = v; mx = fmaxf(mx, v); }
                    mx = fmaxf(mx, __shfl_xor(mx, 16)); mx = fmaxf(mx, __shfl_xor(mx, 32));
                    const float mnew = fmaxf(mrow[tq], mx);
                    const float msafe = (mnew == -INFINITY) ? 0.f : mnew;
                    const float alpha = __builtin_amdgcn_exp2f(mrow[tq] - msafe);
                    float sum = 0.f;
#pragma unroll
                    for (int n = 0; n < 4; ++n) { float p[4];
#pragma unroll
                        for (int j = 0; j < 4; ++j) { p[j] = __builtin_amdgcn_exp2f(s[n][j] - msafe); sum += p[j]; }
                        uint2 w; w.x = cvtpk(p[0], p[1]); w.y = cvtpk(p[2], p[3]);
                        *(uint2*)(Ps + (tq * 64 + qi) * LP + 16 * n + 4 * fq) = w; }
                    sum += __shfl_xor(sum, 16); sum += __shfl_xor(sum, 32);
                    lrow[tq] = lrow[tq] * alpha + sum; mrow[tq] = mnew;
#pragma unroll
                    for (int nd = 0; nd < 4; ++nd) o[tq][nd] = o[tq][nd] * alpha;
                }
            }
            asm volatile("s_waitcnt lgkmcnt(0)" ::: "memory");
#pragma unroll
            for (int tq = 0; tq < 2; ++tq) {
                bool act; int delta = 0;
                if (TYPE == 0) { const int krow = rsA + kb; const int rsq = tq ? rsB : rsA; act = (krow >= rsq) && (krow <= rsq + 7); }
                else { delta = kb - 1 - tq; act = (delta >= -1) && (delta <= 1); }
                int ntlo = 0, nthi = 3;
                if (TYPE == 0) { const int klo_ = min(max(16 * hw - 8, 0), 48), khi_ = min(max(16 * hw + 15 - 8, 0), 48) + 15; ntlo = klo_ >> 4; nthi = khi_ >> 4; }
                else { if (delta < 0) ntlo = hw; else if (delta > 0) nthi = hw; }
                if (act) {
#pragma unroll
                    for (int kk = 0; kk < 2; ++kk) if (2 * kk + 1 >= ntlo && 2 * kk <= nthi) { const bf16x8 bp = ldfrag(Ps + (tq * 64 + qi) * LP + 32 * kk + fq * 8);
#pragma unroll
                        for (int nd = 0; nd < 4; ++nd) o[tq][nd] = mfma16(ldfrag(Vc + (16 * nd + fr) * LP + 32 * kk + fq * 8), bp, o[tq][nd]); }
                }
            }
        }
        if (!stag) { STAGE_NEXT(); }
        __syncthreads();
        cvalid = nvalid;
    }
#undef STAGE_NEXT
#undef KV_STAGE
#undef KB_INFO
#undef KV_PREFETCH
#pragma unroll
    for (int tq = 0; tq < 2; ++tq) { const int tok = (tq ? qtokB : qtokA) + qstr * qi; const float inv = rcpf_(lrow[tq]);
      u16* dst = (TYPE == 0) ? (u16*)(pp->ws + WS_H) + (rowbase + tok) * DM + 256 + h * 64 : (u16*)(pp->ws + WS_DAP) + ((size_t)br * MTOK + rowbase + tok) * 256 + h * 64;
#pragma unroll
      for (int nd = 0; nd < 4; ++nd) { uint2 w; w.x = cvtpk(o[tq][nd][0] * inv, o[tq][nd][1] * inv); w.y = cvtpk(o[tq][nd][2] * inv, o[tq][nd][3] * inv);
          *(uint2*)(dst + 16 * nd + 4 * fq) = w; }
      if (TYPE == 1 && fq == 0) ((float*)(pp->ws + WS_DAL))[((size_t)br * MTOK + rowbase + tok) * 4 + h] = (mrow[tq] + __log2f(lrow[tq])) * 0.6931471805599453f; }
}

constexpr int G1_ZS = 0;
constexpr int G1_WG = G1_ZS + 8192;
constexpr int G1_BG = G1_WG + 8192;
constexpr int G1_SEG = G1_BG + 512;
constexpr int G1_LA = G1_SEG + 4096;
constexpr int G1_T = G1_LA + 2 * 64 * FP * 4;
__device__ __forceinline__ void gla1_phase(int layer, unsigned char* lds, int tid, int bid, int G) {
    PP pp = get_pp();
    const int lane = tid & 63, w = __builtin_amdgcn_readfirstlane(tid >> 6), fr = lane & 15, fq = lane >> 4;
    float* ZS = (float*)(lds + G1_ZS); float* WG = (float*)(lds + G1_WG); float* BG = (float*)(lds + G1_BG); float* SEG = (float*)(lds + G1_SEG); float* LA = (float*)(lds + G1_LA);
    u16* KdT = (u16*)(lds + G1_T); u16* Vt = KdT + 2 * 64 * LP;
    const u16* pbuf = (const u16*)(pp->ws + WS_P);
    const int c = tid >> 3, part = tid & 7;
    int hc = -1;
    uint2 zz = make_uint2(0u, 0u); u32x4 kn = (u32x4){0u, 0u, 0u, 0u}, vn = kn;
#define GLA1_PREFETCH(u_) do { const int b_ = (u_) >> 9, n_ = ((u_) >> 2) & 127, h_ = (u_) & 3; const u16* r_ = pbuf + ((size_t)b_ * L_SEQ + n_ * 64 + c) * DIN; \
        zz = *(const uint2*)(r_ + C_ZA + 4 * part); kn = *(const u32x4*)(r_ + C_KA + h_ * 64 + 8 * part); vn = *(const u32x4*)(r_ + C_VA + h_ * 64 + 8 * part); } while (0)
    if (bid < 1024) GLA1_PREFETCH(bid);
#pragma unroll 1
    for (int uidx = bid; uidx < 1024; uidx += G) {
        const int b = uidx >> 9, n = (uidx >> 2) & 127, h = uidx & 3;
        const int sidx = b * 512 + h * 128 + n;
        __syncthreads();
        { float* z = ZS + c * 32 + 4 * part; z[0] = blo(zz.x); z[1] = bhi(zz.x); z[2] = blo(zz.y); z[3] = bhi(zz.y);
          if (h != hc) { hc = h;
#pragma unroll
              for (int q = 0; q < 4; ++q) { const int i = tid + 512 * q; const int e = i >> 10, rr = (i >> 6) & 15, ch = i & 63; WG[i] = pp->in[4][(((size_t)layer * 2 + e) * 16 + rr) * 256 + h * 64 + ch]; }
              if (tid < 128) { const int e = tid >> 6, ch = tid & 63; BG[tid] = pp->in[5][((size_t)layer * 2 + e) * 256 + h * 64 + ch]; } } }
        const u32x4 kv = kn, vv = vn;
        if (uidx + G < 1024) GLA1_PREFETCH(uidx + G);
        __syncthreads();
        const int ch = tid & 63, seg = __builtin_amdgcn_readfirstlane(tid >> 6);
        float la0[8], la1[8];
#pragma unroll
        for (int i = 0; i < 8; ++i) { const int cc = seg * 8 + i; float a0 = BG[ch], a1 = BG[64 + ch];
#pragma unroll
            for (int rr = 0; rr < 16; ++rr) { a0 += ZS[cc * 32 + rr] * WG[rr * 64 + ch]; a1 += ZS[cc * 32 + 16 + rr] * WG[1024 + rr * 64 + ch]; }
            la0[i] = logsigmoidf_(a0) * (1.f / 16.f); la1[i] = logsigmoidf_(a1) * (1.f / 16.f); }
#pragma unroll
        for (int i = 1; i < 8; ++i) la0[i] += la0[i - 1];
#pragma unroll
        for (int i = 6; i >= 0; --i) la1[i] += la1[i + 1];
        SEG[seg * 64 + ch] = la0[7]; SEG[512 + seg * 64 + ch] = la1[0];
        __syncthreads();
        { float pre0 = 0.f, pre1 = 0.f;
#pragma unroll
          for (int s2 = 0; s2 < 8; ++s2) { if (s2 < seg) pre0 += SEG[s2 * 64 + ch]; if (s2 > seg) pre1 += SEG[512 + s2 * 64 + ch]; }
          float* gb0 = (float*)(pp->ws + WS_GB) + (size_t)sidx * 4096; float* gb1 = gb0 + (size_t)1024 * 4096;
#pragma unroll
          for (int i = 0; i < 8; ++i) { const int cc = seg * 8 + i; const float v0 = la0[i] + pre0, v1 = la1[i] + pre1;
              LA[cc * FP + ch] = v0; LA[(64 + cc) * FP + ch] = v1; gb0[cc * 64 + ch] = v0; gb1[cc * 64 + ch] = v1; } }
        __syncthreads();
        if (tid < 128) { const int e = tid >> 6, k = tid & 63; ((float*)(pp->ws + WS_GDEC))[((size_t)e * 1024 + sidx) * 64 + k] = __expf(LA[(e * 64 + (e ? 0 : 63)) * FP + k]); }
        { float kf[8]; UNPACK8(kv, kf);
#pragma unroll
          for (int j = 0; j < 8; ++j) { const int k = 8 * part + j;
              KdT[k * LP + c] = (u16)f2bf(kf[j] * __expf(LA[63 * FP + k] - LA[c * FP + k]));
              KdT[(64 + k) * LP + c] = (u16)f2bf(kf[j] * __expf(LA[64 * FP + k] - LA[(64 + c) * FP + k])); }
          u16* vt = Vt + (8 * part) * LP + c; VT_SCATTER(vt, vv); }
        __syncthreads();
        { const int e = w >> 2, mt = w & 3;
          const bf16x8 a0 = ldfrag(KdT + (e * 64 + 16 * mt + fr) * LP + 8 * fq), a1 = ldfrag(KdT + (e * 64 + 16 * mt + fr) * LP + 32 + 8 * fq);
          float* kvout = (float*)(pp->ws + WS_GLA) + ((size_t)e * 1024 + sidx) * 4096;
#pragma unroll
          for (int nt = 0; nt < 4; ++nt) { f32x4 acc = (f32x4){0.f, 0.f, 0.f, 0.f};
              acc = mfma16(a0, ldfrag(Vt + (16 * nt + fr) * LP + 8 * fq), acc); acc = mfma16(a1, ldfrag(Vt + (16 * nt + fr) * LP + 32 + 8 * fq), acc);
#pragma unroll
              for (int j = 0; j < 4; ++j) kvout[(16 * mt + 4 * fq + j) * 64 + 16 * nt + fr] = acc[j]; } }
    }
#undef GLA1_PREFETCH
}

__device__ __forceinline__ void gla2_scan(int tid, int bid, int G) {
    PP pp = get_pp();
    float* KV = (float*)(pp->ws + WS_GLA); const float* DEC = (const float*)(pp->ws + WS_GDEC);
    if (tid >= 256) return;
    for (int idx = bid * 256 + tid; idx < 16 * 4096; idx += G * 256) {
        const int seq = idx >> 12, kvi = idx & 4095, k = kvi >> 6; const int e = seq >> 3;
        float S = 0.f;
#pragma unroll 32
        for (int i = 0; i < 128; ++i) { const int n = e ? 127 - i : i; const size_t u = (size_t)seq * 128 + n;
            const float t = KV[u * 4096 + kvi]; const float d = DEC[u * 64 + k]; KV[u * 4096 + kvi] = S; S = S * d + t; }
    }
}

constexpr int G3_TB = 64 * LP * 2;
constexpr int G3_OS = 11 * G3_TB;
__device__ __forceinline__ void gla3_phase(int layer, unsigned char* lds, int tid, int bid, int G) {
    PP pp = get_pp();
    const int lane = tid & 63, w = __builtin_amdgcn_readfirstlane(tid >> 6), fr = lane & 15, fq = lane >> 4;
    u16* T = (u16*)lds;
    u16* Vt = T + 10 * 64 * LP; float* OS = (float*)(lds + G3_OS);
    const u16* pbuf = (const u16*)(pp->ws + WS_P);
    const int c = tid >> 3, kc = tid & 7;
    u32x4 qn, kn, vn, gn; f32x4 bn[2][2], mn[2][2], sn[2][2];
#define GLA3_PREFETCH(u_) do { const int b_ = (u_) >> 9, n_ = ((u_) >> 2) & 127, h_ = (u_) & 3; const int s_ = b_ * 512 + h_ * 128 + n_; \
        const u16* r_ = pbuf + ((size_t)b_ * L_SEQ + n_ * 64 + c) * DIN + h_ * 64 + 8 * kc; \
        qn = *(const u32x4*)(r_ + C_QA); kn = *(const u32x4*)(r_ + C_KA); vn = *(const u32x4*)(r_ + C_VA); gn = *(const u32x4*)(r_ + C_GA); \
        _Pragma("unroll") for (int e_ = 0; e_ < 2; ++e_) { const float* gb_ = (const float*)(pp->ws + WS_GB) + ((size_t)e_ * 1024 + s_) * 4096; const float* sg_ = (const float*)(pp->ws + WS_GLA) + ((size_t)e_ * 1024 + s_) * 4096; \
            bn[e_][0] = __builtin_nontemporal_load((const f32x4*)(gb_ + c * 64 + 8 * kc)); bn[e_][1] = __builtin_nontemporal_load((const f32x4*)(gb_ + c * 64 + 8 * kc + 4)); \
            mn[e_][0] = *(const f32x4*)(gb_ + 32 * 64 + 8 * kc); mn[e_][1] = *(const f32x4*)(gb_ + 32 * 64 + 8 * kc + 4); \
            sn[e_][0] = __builtin_nontemporal_load((const f32x4*)(sg_ + c * 64 + 8 * kc)); sn[e_][1] = __builtin_nontemporal_load((const f32x4*)(sg_ + c * 64 + 8 * kc + 4)); } } while (0)
    if (bid < 1024) GLA3_PREFETCH(bid);
#pragma unroll 1
    for (int uidx = bid; uidx < 1024; uidx += G) {
        const int b = uidx >> 9, n = (uidx >> 2) & 127, h = uidx & 3;
        const size_t tok0 = (size_t)b * L_SEQ + n * 64;
        __syncthreads();
        { float qf[8], kf[8]; UNPACK8(qn, qf); UNPACK8(kn, kf);
#pragma unroll
          for (int e = 0; e < 2; ++e) {
              const f32x4 b0 = bn[e][0], b1 = bn[e][1], m0 = mn[e][0], m1 = mn[e][1];
              const float bv[8] = {b0.x, b0.y, b0.z, b0.w, b1.x, b1.y, b1.z, b1.w}; const float bm[8] = {m0.x, m0.y, m0.z, m0.w, m1.x, m1.y, m1.z, m1.w};
              float a[8], bb[8], cc[8];
#pragma unroll
              for (int j = 0; j < 8; ++j) { a[j] = qf[j] * 0.125f * __expf(bv[j] - bm[j]); bb[j] = kf[j] * __expf(bm[j] - bv[j]); cc[j] = qf[j] * 0.125f * __expf(bv[j]); }
              u32x4 o; PACK8(o, a); *(u32x4*)(T + ((0 + e) * 64 + c) * LP + 8 * kc) = o; PACK8(o, bb); *(u32x4*)(T + ((2 + e) * 64 + c) * LP + 8 * kc) = o; PACK8(o, cc); *(u32x4*)(T + ((4 + e) * 64 + c) * LP + 8 * kc) = o;
              const f32x4 s0 = sn[e][0], s1 = sn[e][1];
              u16* st = T + ((6 + e) * 64 + 8 * kc) * LP + c;
              st[0 * LP] = (u16)f2bf(s0.x); st[1 * LP] = (u16)f2bf(s0.y); st[2 * LP] = (u16)f2bf(s0.z); st[3 * LP] = (u16)f2bf(s0.w);
              st[4 * LP] = (u16)f2bf(s1.x); st[5 * LP] = (u16)f2bf(s1.y); st[6 * LP] = (u16)f2bf(s1.z); st[7 * LP] = (u16)f2bf(s1.w); }
          u16* vt = Vt + (8 * kc) * LP + c; VT_SCATTER(vt, vn); }
        const u32x4 gcur = gn;
        if (uidx + G < 1024) GLA3_PREFETCH(uidx + G);
        __syncthreads();
        { const int e = w >> 2, mt = w & 3;
          const u16* Qe = T + (0 + e) * 64 * LP; const u16* Ke = T + (2 + e) * 64 * LP; u16* At = T + (8 + e) * 64 * LP;
          const bf16x8 a0 = ldfrag(Qe + (16 * mt + fr) * LP + 8 * fq), a1 = ldfrag(Qe + (16 * mt + fr) * LP + 32 + 8 * fq);
#pragma unroll
          for (int nt = 0; nt < 4; ++nt) { f32x4 acc = (f32x4){0.f, 0.f, 0.f, 0.f};
              acc = mfma16(a0, ldfrag(Ke + (16 * nt + fr) * LP + 8 * fq), acc); acc = mfma16(a1, ldfrag(Ke + (16 * nt + fr) * LP + 32 + 8 * fq), acc);
#pragma unroll
              for (int j = 0; j < 4; ++j) { const int cq = 16 * mt + 4 * fq + j, s = 16 * nt + fr; const bool ok = (e == 0) ? (s <= cq) : (s >= cq);
                  At[cq * LP + s] = (u16)f2bf(ok ? acc[j] : 0.f); } } }
        __syncthreads();
        { const int mt = w >> 1;
          f32x4 oacc[2]; oacc[0] = (f32x4){0.f, 0.f, 0.f, 0.f}; oacc[1] = oacc[0];
#pragma unroll
          for (int e = 0; e < 2; ++e) { const u16* At = T + (8 + e) * 64 * LP; const u16* Qb = T + (4 + e) * 64 * LP; const u16* St = T + (6 + e) * 64 * LP;
#pragma unroll
              for (int kk = 0; kk < 2; ++kk) { const bf16x8 aA = ldfrag(At + (16 * mt + fr) * LP + 32 * kk + 8 * fq), aQ = ldfrag(Qb + (16 * mt + fr) * LP + 32 * kk + 8 * fq);
#pragma unroll
                  for (int t = 0; t < 2; ++t) { const int nt = (w & 1) * 2 + t;
                      oacc[t] = mfma16(aA, ldfrag(Vt + (16 * nt + fr) * LP + 32 * kk + 8 * fq), oacc[t]);
                      oacc[t] = mfma16(aQ, ldfrag(St + (16 * nt + fr) * LP + 32 * kk + 8 * fq), oacc[t]); } } }
#pragma unroll
          for (int t = 0; t < 2; ++t) { const int nt = (w & 1) * 2 + t;
#pragma unroll
              for (int j = 0; j < 4; ++j) OS[(16 * mt + 4 * fq + j) * FP + 16 * nt + fr] = oacc[t][j]; } }
        __syncthreads();
        { float ov[8]; float ss = 0.f;
#pragma unroll
          for (int j = 0; j < 8; ++j) { ov[j] = OS[c * FP + 8 * kc + j]; ss += ov[j] * ov[j]; }
          ss += __shfl_xor(ss, 1); ss += __shfl_xor(ss, 2); ss += __shfl_xor(ss, 4);
          const float rs = rsqrtf(ss * (1.f / 64.f) + EPS);
          float gf[8]; UNPACK8(gcur, gf);
          const float* ng = pp->in[6] + (size_t)layer * 256 + h * 64 + 8 * kc;
#pragma unroll
          for (int j = 0; j < 8; ++j) ov[j] = ov[j] * rs * ng[j] * (gf[j] * sigmoidf_(gf[j]));
          u32x4 o; PACK8(o, ov);
          *(u32x4*)((u16*)(pp->ws + WS_H) + (tok0 + c) * DM + h * 64 + 8 * kc) = o; }
    }
#undef GLA3_PREFETCH
}

constexpr int LR_XF = 0;
constexpr int LR_XB = LR_XF + 64 * FP * 4;
constexpr int LR_A = LR_XB + 64 * LP * 2;
constexpr int LR_U = LR_A + 2 * 64 * FP * 4;
constexpr int LR_END = LR_U + 2 * 64 * FP * 4;
template <int PASS>
__device__ __forceinline__ void lru_phase(int layer, unsigned char* lds, int tid, int bid, int G) {
    PP pp = get_pp();
    const int lane = tid & 63, w = __builtin_amdgcn_readfirstlane(tid >> 6), fr = lane & 15, fq = lane >> 4;
    float* XF = (float*)(lds + LR_XF); u16* XB = (u16*)(lds + LR_XB); float* AS = (float*)(lds + LR_A); float* US = (float*)(lds + LR_U);
    const u16* pbuf = (const u16*)(pp->ws + WS_P);
    const int t = tid >> 3, cc = tid & 7;
    const int mt = w & 3, e = w >> 2;
    int hc = -1;
    bf16x8 wa[4][2], wx[4][2]; float ba[4], bx[4], sp[4], cw[4][8], cb[8];
    u32x4 xt[4], gnext = (u32x4){0u, 0u, 0u, 0u};
#define LRU_PREFETCH(u_) do { const int b_ = (u_) >> 9, n_ = ((u_) >> 2) & 127, h_ = (u_) & 3; const size_t rb_ = (size_t)b_ * L_SEQ; \
        _Pragma("unroll") for (int jj = 0; jj < 4; ++jj) { const int tt_ = n_ * 64 + t - 2 + jj; \
            xt[jj] = (tt_ >= 0 && tt_ < L_SEQ) ? *(const u32x4*)(pbuf + (rb_ + tt_) * DIN + C_XC + h_ * 64 + 8 * cc) : (u32x4){0u, 0u, 0u, 0u}; } \
        if (PASS == 3) gnext = *(const u32x4*)(pbuf + (rb_ + n_ * 64 + t) * DIN + C_GC + h_ * 64 + 8 * cc); } while (0)
    if (bid < 1024) LRU_PREFETCH(bid);
#pragma unroll 1
    for (int uidx = bid; uidx < 1024; uidx += G) {
        const int b = uidx >> 9, n = (uidx >> 2) & 127, h = uidx & 3;
        const size_t rowbase = (size_t)b * L_SEQ; const int t0 = n * 64;
        if (h != hc) { hc = h;
            const u16* WA = (const u16*)(pp->ws + WS_LRUW) + ((((size_t)layer * 2 + 0) * 2 + e) * 4 + h) * 4096;
            const u16* WX = (const u16*)(pp->ws + WS_LRUW) + ((((size_t)layer * 2 + 1) * 2 + e) * 4 + h) * 4096;
#pragma unroll
            for (int nt = 0; nt < 4; ++nt) { const int jc = 16 * nt + fr; const int chg = h * 64 + jc;
                wa[nt][0] = ldfrag(WA + jc * 64 + 8 * fq); wa[nt][1] = ldfrag(WA + jc * 64 + 32 + 8 * fq);
                wx[nt][0] = ldfrag(WX + jc * 64 + 8 * fq); wx[nt][1] = ldfrag(WX + jc * 64 + 32 + 8 * fq);
                ba[nt] = pp->in[11][((size_t)layer * 2 + e) * 256 + chg]; bx[nt] = pp->in[13][((size_t)layer * 2 + e) * 256 + chg];
                sp[nt] = softplusf_(-pp->in[14][((size_t)layer * 2 + e) * 256 + chg]); }
#pragma unroll
            for (int j = 0; j < 8; ++j) { cb[j] = pp->in[9][(size_t)layer * 256 + h * 64 + 8 * cc + j];
#pragma unroll
                for (int jj = 0; jj < 4; ++jj) cw[jj][j] = pp->in[8][((size_t)layer * 4 + jj) * 256 + h * 64 + 8 * cc + j]; } }
        __syncthreads();
        { float acc[8];
#pragma unroll
          for (int j = 0; j < 8; ++j) acc[j] = cb[j];
#pragma unroll
          for (int jj = 0; jj < 4; ++jj) { float xf[8]; UNPACK8(xt[jj], xf);
#pragma unroll
              for (int j = 0; j < 8; ++j) acc[j] += xf[j] * cw[jj][j]; }
#pragma unroll
          for (int j = 0; j < 8; ++j) XF[t * FP + 8 * cc + j] = acc[j];
          u32x4 o; PACK8(o, acc); *(u32x4*)(XB + t * LP + 8 * cc) = o; }
        const u32x4 gcur = gnext;
        float hin = 0.f; size_t cidx = 0;
        if (tid < 128) { const int e2 = tid >> 6, ch = tid & 63; cidx = ((size_t)(e2 * 2 + b) * 128 + n) * 256 + h * 64 + ch; if (PASS == 3) hin = ((const float*)(pp->ws + WS_LRUH))[cidx]; }
        if (uidx + G < 1024) LRU_PREFETCH(uidx + G);
        __syncthreads();
        { const bf16x8 a0 = ldfrag(XB + (16 * mt + fr) * LP + 8 * fq), a1 = ldfrag(XB + (16 * mt + fr) * LP + 32 + 8 * fq);
#pragma unroll
          for (int nt = 0; nt < 4; ++nt) { const int jc = 16 * nt + fr;
              f32x4 ar = (f32x4){0.f, 0.f, 0.f, 0.f}, ai = ar;
              ar = mfma16(a0, wa[nt][0], ar); ar = mfma16(a1, wa[nt][1], ar);
              ai = mfma16(a0, wx[nt][0], ai); ai = mfma16(a1, wx[nt][1], ai);
#pragma unroll
              for (int j = 0; j < 4; ++j) { const int tt = 16 * mt + 4 * fq + j;
                  const float rg = sigmoidf_(ar[j] + ba[nt]), ig = sigmoidf_(ai[j] + bx[nt]);
                  const float la = -8.f * rg * sp[nt]; const float a = __expf(la); const float u = __builtin_amdgcn_sqrtf(fmaxf(1.f - a * a, 0.f)) * (ig * XF[tt * FP + jc]);
                  AS[(e * 64 + tt) * FP + jc] = a; US[(e * 64 + tt) * FP + jc] = u; } } }
        __syncthreads();
        if (tid < 128) { const int e2 = tid >> 6, ch = tid & 63;
            if (PASS == 1) { float Pp = 1.f, H = 0.f;
#pragma unroll 32
                for (int i = 0; i < 64; ++i) { const int tt = e2 ? 63 - i : i; const float a = AS[(e2 * 64 + tt) * FP + ch], u = US[(e2 * 64 + tt) * FP + ch]; Pp *= a; H = a * H + u; }
                ((float*)(pp->ws + WS_LRUA))[cidx] = Pp; ((float*)(pp->ws + WS_LRUH))[cidx] = H; }
            else { float H = hin;
#pragma unroll 32
                for (int i = 0; i < 64; ++i) { const int tt = e2 ? 63 - i : i; const float a = AS[(e2 * 64 + tt) * FP + ch], u = US[(e2 * 64 + tt) * FP + ch]; H = a * H + u; US[(e2 * 64 + tt) * FP + ch] = H; } } }
        if (PASS == 3) {
            __syncthreads();
            float gf[8], ov[8]; UNPACK8(gcur, gf);
#pragma unroll
            for (int j = 0; j < 8; ++j) ov[j] = (US[t * FP + 8 * cc + j] + US[(64 + t) * FP + 8 * cc + j]) * gelu_tanh(gf[j]);
            u32x4 o; PACK8(o, ov);
            *(u32x4*)((u16*)(pp->ws + WS_H) + (rowbase + t0 + t) * DM + 512 + h * 64 + 8 * cc) = o;
        }
    }
#undef LRU_PREFETCH
}
__device__ __forceinline__ void lru2_scan(int tid, int bid, int G) {
    PP pp = get_pp();
    const float* A = (const float*)(pp->ws + WS_LRUA); float* Hh = (float*)(pp->ws + WS_LRUH);
    if (tid < 256) return;
    for (int idx = (tid - 256) * G + bid; idx < 2 * 2 * 256; idx += 256 * G) { const int ch = idx & 255, eb = idx >> 8, e = eb >> 1;
        float H = 0.f;
#pragma unroll 32
        for (int i = 0; i < 128; ++i) { const int n = e ? 127 - i : i; const size_t c = ((size_t)eb * 128 + n) * 256 + ch; const float a = A[c], hl = Hh[c]; Hh[c] = H; H = a * H + hl; } }
}
__device__ __forceinline__ void da_combine(int gt, int ngt) {
    PP pp = get_pp();
    const u16* dap = (const u16*)(pp->ws + WS_DAP); const float* dal = (const float*)(pp->ws + WS_DAL); u16* y = (u16*)(pp->ws + WS_H);
    constexpr int NI = 4;
    for (int idx0 = gt; idx0 < MTOK * 32; idx0 += NI * ngt) {
        u32x4 v[NI][3]; float l[NI][3]; bool has[NI]; int tok[NI], c[NI];
#pragma unroll
        for (int q = 0; q < NI; ++q) { const int idx = idx0 + q * ngt; has[q] = idx < MTOK * 32; const int id2 = has[q] ? idx : idx0; tok[q] = id2 >> 5; c[q] = id2 & 31; const int h = c[q] >> 3;
#pragma unroll
            for (int g = 0; g < 3; ++g) { l[q][g] = dal[((size_t)g * MTOK + tok[q]) * 4 + h]; v[q][g] = __builtin_nontemporal_load((const u32x4*)(dap + ((size_t)g * MTOK + tok[q]) * 256 + 8 * c[q])); } }
#pragma unroll
        for (int q = 0; q < NI; ++q) {
            const float mx = fmaxf(l[q][0], fmaxf(l[q][1], l[q][2])); float w0 = __expf(l[q][0] - mx), w1 = __expf(l[q][1] - mx), w2 = __expf(l[q][2] - mx); const float inv = rcpf_(w0 + w1 + w2); w0 *= inv; w1 *= inv; w2 *= inv;
            float f0[8], f1[8], f2[8], ov[8]; UNPACK8(v[q][0], f0); UNPACK8(v[q][1], f1); UNPACK8(v[q][2], f2);
#pragma unroll
            for (int j = 0; j < 8; ++j) ov[j] = w0 * f0[j] + w1 * f1[j] + w2 * f2[j];
            u32x4 o; PACK8(o, ov);
            if (has[q]) *(u32x4*)(y + (size_t)tok[q] * DM + 768 + 8 * c[q]) = o; }
    }
}

#define LAS __attribute__((address_space(3)))
#define XB_TMO      128
#define XB_XCNT(j)  (256  + 64 * (j))
#define XB_XSUB(j)  (1280 + 64 * (j))
#define XB_XGEN(j)  (2304 + 64 * (j))
#define XB_TOP      3328
#define XB_TOPGEN   3392
#define XCD_BAR_WORDS 3456
#define XB_SPIN_CAP (1u << 18)

__device__ __forceinline__ unsigned xb_ld(unsigned* p)              { return __hip_atomic_load(p, __ATOMIC_RELAXED, __HIP_MEMORY_SCOPE_AGENT); }
__device__ __forceinline__ unsigned xb_add(unsigned* p, unsigned v) { return __hip_atomic_fetch_add(p, v, __ATOMIC_RELAXED, __HIP_MEMORY_SCOPE_AGENT); }
__device__ __forceinline__ unsigned xb_xcc_id() { return (unsigned)__builtin_amdgcn_s_getreg((3 << 11) | 20) & 0xFu; }
#define XB_SPIN(cond, bar) do { unsigned _sp = 0; while (cond) { __builtin_amdgcn_s_sleep(1); \
    if ((++_sp & 255u) == 0u) { if (xb_ld(&(bar)[XB_TMO])) break; if (_sp > XB_SPIN_CAP) { atomicAdd(&(bar)[XB_TMO], 1u); break; } } } } while (0)

struct XcdBarrier {
    unsigned* bar; unsigned x;
    volatile LAS unsigned* st;
};

__device__ __forceinline__ XcdBarrier xcd_barrier_post(unsigned* bar, volatile LAS unsigned* st) {
    XcdBarrier b; b.bar = bar; b.x = xb_xcc_id(); b.st = st;
    if (threadIdx.x == 0) (void)xb_add(&bar[XB_XCNT(b.x)], 1u);
    return b;
}
__device__ __forceinline__ void xcd_barrier_complete(unsigned* bar, unsigned x, unsigned& nloc, unsigned& nx) {
    const unsigned G = gridDim.x * gridDim.y * gridDim.z;
    unsigned sum, cnt, mine, sp = 0u;
    for (;;) {
        sum = 0u; cnt = 0u; mine = 0u;
#pragma unroll
        for (unsigned j = 0; j < 16; ++j) { const unsigned c = xb_ld(&bar[XB_XCNT(j)]); sum += c; cnt += (c > 0u) ? 1u : 0u; mine = (j == x) ? c : mine; }
        if (sum == G) break;
        __builtin_amdgcn_s_sleep(1);
        if ((++sp & 255u) == 0u) { if (xb_ld(&bar[XB_TMO])) break; if (sp > XB_SPIN_CAP) { atomicAdd(&bar[XB_TMO], 1u); break; } }
    }
    nloc = mine > 0u ? mine : 1u; nx = cnt > 0u ? cnt : 1u;
}

__device__ __forceinline__ void xcd_barrier(const XcdBarrier& b) {
    asm volatile("s_waitcnt vmcnt(0)" ::: "memory");
    __syncthreads();
    if (threadIdx.x == 0) {
        unsigned* bar = b.bar;
        __builtin_amdgcn_s_waitcnt(0);
        unsigned nloc = b.st[0], nx = b.st[1];
        if (nloc == 0u) { xcd_barrier_complete(bar, b.x, nloc, nx); b.st[0] = nloc; b.st[1] = nx; }
        const unsigned old = xb_add(&bar[XB_XSUB(b.x)], 1u);
        const unsigned gen = old / nloc;
        if (old + 1u == (gen + 1u) * nloc) {
            __builtin_amdgcn_fence(__ATOMIC_RELEASE, "agent");
            asm volatile("s_waitcnt vmcnt(0)" ::: "memory");
            const unsigned og = xb_add(&bar[XB_TOP], 1u);
            const unsigned tg = og / nx;
            if (og + 1u == (tg + 1u) * nx) xb_add(&bar[XB_TOPGEN], 1u);
            else XB_SPIN(xb_ld(&bar[XB_TOPGEN]) == tg, bar);
            __builtin_amdgcn_fence(__ATOMIC_ACQUIRE, "agent");
            xb_add(&bar[XB_XGEN(b.x)], 1u);
            asm volatile("s_waitcnt vmcnt(0)" ::: "memory");
        } else {
            XB_SPIN(xb_ld(&bar[XB_XGEN(b.x)]) == gen, bar);
            __builtin_amdgcn_fence(__ATOMIC_ACQUIRE, "agent");
            asm volatile("s_waitcnt vmcnt(0)" ::: "memory");
        }
    }
    __syncthreads();
}


#define R_G 1
#define R_PRO 1
#define PROBE_MASK 0
#define XSYNC 0
#define R_NA 1
#define R_DA 1
#define R_GLA1 1
#define R_LRU1 1
#define R_GLA3 1
#define R_LRU3 1
#define R_DAC 1
__global__ void __launch_bounds__(NTHR, 2) hybrid_fwd(Params P) {
    extern __shared__ __attribute__((aligned(16))) unsigned char lds_raw[];
    cg::grid_group grid = cg::this_grid();
    const int ph_lo = P.ph_lo, ph_hi = P.ph_hi;
    int again = 0;
    { volatile LAS unsigned* st0 = (volatile LAS unsigned*)((LAS unsigned char*)lds_raw + (LDS_BYTES - 256));
      if (threadIdx.x < 2) st0[threadIdx.x] = 0u;
      __syncthreads();
      (void)xcd_barrier_post((unsigned*)(P.ws + WS_CTL), st0); }
#define GSYNC() do { XcdBarrier xb_; xb_.bar = (unsigned*)(get_pp()->ws + WS_CTL); xb_.x = xb_xcc_id(); xb_.st = (volatile LAS unsigned*)((LAS unsigned char*)lds_raw + (LDS_BYTES - 256)); xcd_barrier(xb_); } while (0)
    for (int ph = ph_lo; ph < ph_hi; ++ph) {
        PP pp = get_pp(); unsigned char* ws = pp->ws;
        int tid = threadIdx.x; asm volatile("" : "+v"(tid));
        int bid = blockIdx.x; asm volatile("" : "+s"(bid));
        int G = gridDim.x; asm volatile("" : "+s"(G));
        PG8_LAS unsigned char* l3 = (PG8_LAS unsigned char*)lds_raw; asm volatile("" : "+s"(l3));
        unsigned char* lds = (unsigned char*)l3;
        const int lane = tid & 63, wave = __builtin_amdgcn_readfirstlane(tid >> 6);
        const int gw = bid * 8 + wave, ngw = G * 8;
        const int gt = bid * NTHR + tid, ngt = G * NTHR;
        if (ph == 0) { for (int rep = 0; rep < R_PRO; ++rep) prologue(tid, lane, wave, bid, G, lds); }
        else {
            const int l = (ph - 1) / 9, t = (ph - 1) % 9;
            const bool fusedn = FUSE_NORM && (G == 256);
            if (fusedn && (t == 5 || t == 8)) continue;
            if (fusedn && (t == 4 || t == 7)) {
                pg8::Gemm g; pg8::EpiRms2 E;
                const int inst = l * 2 + (t == 7);
                pg8::PanelStats s1{(unsigned*)(ws + WS_XB), (unsigned*)(ws + WS_CTL + CTL_SEAM) + (size_t)(inst * 2 + 0) * 4096, (unsigned*)(ws + WS_CTL + CTL_TMO), DM / 256, EPS, 0x700u};
                pg8::PanelStats s2{(unsigned*)(ws + WS_XB + 524288), (unsigned*)(ws + WS_CTL + CTL_SEAM) + (size_t)(inst * 2 + 1) * 4096, (unsigned*)(ws + WS_CTL + CTL_TMO), DM / 256, EPS, 0x780u};
                if (t == 4) { g = pg8::Gemm{(const u16*)(ws + WS_H), (const u16*)(ws + WS_WOUT) + (size_t)l * DM * DM, MTOK, DM, DM};
                    E = pg8::EpiRms2{l == 0 ? pp->in[0] : pp->out, pp->out, (u16*)(ws + WS_H), DM, pp->in[2] + (size_t)l * DM, pp->in[16] + (size_t)l * DM, s1, s2}; }
                else { g = pg8::Gemm{(const u16*)(ws + WS_P), (const u16*)(ws + WS_WF2) + (size_t)l * DM * DFF, MTOK, DM, DFF};
                    E = pg8::EpiRms2{pp->out, pp->out, (u16*)(ws + WS_H), DM, pp->in[17] + (size_t)l * DM, pp->in[1] + (size_t)(l + 1 < DEPTH ? l + 1 : l) * DM, s1, s2}; }
                pg8::StaticOrder S; S.init(g.M, g.N, G, bid);
                pg8::gemm_phase<pg8::EpiRms2, pg8::StaticOrder, false, true>(l3, g, S, E, tid);
            } else
#ifndef SKIP_G1
            if (t == 0 || t == 4 || t == 7) {
                pg8::Gemm g; pg8::EpiStore E;
                if (t == 0) { g = pg8::Gemm{(const u16*)(ws + WS_H), (const u16*)(ws + WS_WIN) + (size_t)l * DIN_PAD * DM, MTOK, ZSPLIT ? 3072 : DIN_PAD, DM}; E = ZSPLIT ? pg8::EpiStore{(u16*)(ws + WS_P), DIN, 3072, 1024, 32} : pg8::EpiStore{(u16*)(ws + WS_P), DIN, DIN, 1 << 30, 0}; }
                else if (t == 4) { g = pg8::Gemm{(const u16*)(ws + WS_H), (const u16*)(ws + WS_WOUT) + (size_t)l * DM * DM, MTOK, DM, DM}; E = pg8::EpiStore{(u16*)(ws + WS_P), DM, DM, 1 << 30, 0}; }
                else { g = pg8::Gemm{(const u16*)(ws + WS_P), (const u16*)(ws + WS_WF2) + (size_t)l * DM * DFF, MTOK, DM, DFF}; E = pg8::EpiStore{(u16*)(ws + WS_GLA), DM, DM, 1 << 30, 0}; }
                pg8::StaticOrder S; S.init(g.M, g.N, G, bid);
                for (int rep = 0; rep < R_G; ++rep) pg8::gemm_phase<pg8::EpiStore, pg8::StaticOrder, true, true>(l3, g, S, E, tid);
                if (ZSPLIT && t == 0) {
                    const int w = __builtin_amdgcn_readfirstlane(tid >> 6), fr = lane & 15, fq = lane >> 4, mt = w & 3, kh = w >> 2;
                    float* red = (float*)lds;
                    for (int rb = bid; rb < MTOK / 64; rb += G) {
                        const u16* A = (const u16*)(ws + WS_H) + (size_t)(rb * 64 + 16 * mt + fr) * DM + kh * 512 + 8 * fq;
                        const u16* B0 = (const u16*)(ws + WS_WIN) + ((size_t)l * DIN_PAD + 3072 + fr) * DM + kh * 512 + 8 * fq; const u16* B1 = B0 + 16 * DM;
                        f32x4 z0 = (f32x4){0.f, 0.f, 0.f, 0.f}, z1 = z0;
#pragma unroll
                        for (int hb = 0; hb < 2; ++hb) {
                            bf16x8 av[8], b0v[8], b1v[8];
#pragma unroll
                            for (int s = 0; s < 8; ++s) { av[s] = ldfrag(A + 32 * (8 * hb + s)); b0v[s] = ldfrag(B0 + 32 * (8 * hb + s)); b1v[s] = ldfrag(B1 + 32 * (8 * hb + s)); }
                            __builtin_amdgcn_sched_barrier(0);
#pragma unroll
                            for (int s = 0; s < 8; ++s) { z0 = mfma16(av[s], b0v[s], z0); z1 = mfma16(av[s], b1v[s], z1); }
                        }
                        __syncthreads();
                        if (kh == 1) {
#pragma unroll
                            for (int j = 0; j < 4; ++j) { red[(16 * mt + 4 * fq + j) * 33 + fr] = z0[j]; red[(16 * mt + 4 * fq + j) * 33 + 16 + fr] = z1[j]; } }
                        __syncthreads();
                        if (kh == 0) { u16* pz = (u16*)(ws + WS_P) + (size_t)(rb * 64 + 16 * mt + 4 * fq) * DIN + C_ZA;
#pragma unroll
                            for (int j = 0; j < 4; ++j) { pz[(size_t)j * DIN + fr] = (u16)f2bf(z0[j] + red[(16 * mt + 4 * fq + j) * 33 + fr]); pz[(size_t)j * DIN + 16 + fr] = (u16)f2bf(z1[j] + red[(16 * mt + 4 * fq + j) * 33 + 16 + fr]); } }
                    }
                }
            } else
#endif
#ifndef SKIP_G3
            if (t == 6) {
                pg8::Gemm g{(const u16*)(ws + WS_H), (const u16*)(ws + WS_WF1) + (size_t)l * 2 * DFF * DM, MTOK, 2 * DFF, DM};
                pg8::EpiSwiGLU E{(u16*)(ws + WS_P), DFF};
                pg8::StaticOrder S; S.init(g.M, g.N, G, bid);
                for (int rep = 0; rep < R_G; ++rep) pg8::gemm_phase<pg8::EpiSwiGLU, pg8::StaticOrder, true, true>(l3, g, S, E, tid);
            } else
#endif
#ifndef SKIP_M1
            if (t == 1) {
                const int half = tid >> 8, ht = tid & 255; unsigned char* hl = lds + half * ATT_HALF_BYTES;
                for (int rep = 0; rep < R_NA; ++rep) for (int pi = bid; pi < 256; pi += G) attn_unit<0>(l, 2 * pi + half, hl, ht);
                for (int rep = 0; rep < R_DA; ++rep) for (int pi = bid; pi < 768; pi += G) attn_unit<1>(l, 2 * pi + half, hl, ht);
                for (int rep = 0; rep < R_GLA1; ++rep) gla1_phase(l, lds, tid, bid, G);
                for (int rep = 0; rep < R_LRU1; ++rep) lru_phase<1>(l, lds, tid, bid, G);
            } else
#endif
            if (t == 2) {
                gla2_scan(tid, bid, G);
                lru2_scan(tid, bid, G);
            } else
#ifndef SKIP_M3
            if (t == 3) {
                for (int rep = 0; rep < R_GLA3; ++rep) gla3_phase(l, lds, tid, bid, G);
                for (int rep = 0; rep < R_LRU3; ++rep) lru_phase<3>(l, lds, tid, bid, G);
                for (int rep = 0; rep < R_DAC; ++rep) da_combine(gt, ngt);
            } else
#endif
            if (t == 5) {
                row_pass(1, l == 0 ? pp->in[0] : pp->out, pp->out, (const u16*)(ws + WS_P), pp->in[2] + (size_t)l * DM, pp->in[16] + (size_t)l * DM, (u16*)(ws + WS_H), gw, ngw, lane);
            } else if (t == 8) {
                row_pass(1, pp->out, pp->out, (const u16*)(ws + WS_GLA), pp->in[17] + (size_t)l * DM, (l + 1 < DEPTH) ? pp->in[1] + (size_t)(l + 1) * DM : nullptr, (u16*)(ws + WS_H), gw, ngw, lane);
            }
        }
        if (PROBE_MASK && ph > 0 && ((PROBE_MASK >> ((ph - 1) % 9)) & 1) && !again) { again = 1; --ph; GSYNC(); continue; }
        again = 0;
        for (int xs = 0; xs < XSYNC; ++xs) GSYNC();
        if (ph + 1 < ph_hi) { if (ph_hi > 4096) grid.sync();
            GSYNC(); }
    }
}

#ifndef N_LAUNCH_MODE
#define N_LAUNCH_MODE 1
#endif
constexpr int N_PHASES = 1 + 9 * DEPTH;
extern "C" void kernel_launch(void* const* d_in, const int* in_sizes, int n_in, void* d_out, int out_size, void* d_ws, size_t ws_size, hipStream_t stream) {
    static int grid = 0;
    if (grid == 0) {
        if (n_in != 20 || ws_size < WS_END) { fprintf(stderr, "kernel_launch: need 20 inputs and %zu B workspace (got %d, %zu)\n", (size_t)WS_END, n_in, ws_size); grid = -1; return; }
        int dev = 0, cus = 0, per_cu = 0;
        hipGetDevice(&dev); hipDeviceGetAttribute(&cus, hipDeviceAttributeMultiprocessorCount, dev);
        if (hipFuncSetAttribute((const void*)hybrid_fwd, hipFuncAttributeMaxDynamicSharedMemorySize, LDS_BYTES) != hipSuccess) { fprintf(stderr, "hipFuncSetAttribute failed\n"); grid = -1; return; }
        if (hipOccupancyMaxActiveBlocksPerMultiprocessor(&per_cu, (const void*)hybrid_fwd, NTHR, LDS_BYTES) != hipSuccess || per_cu < 1) { fprintf(stderr, "occupancy query: %d\n", per_cu); per_cu = 1; }
        (void)hipGetLastError();
        grid = cus * 1;
        if (per_cu < 1) grid = -1;
    }
    if (grid < 0) return;
    if (hipMemsetAsync((char*)d_ws + WS_CTL, 0, CTL_BYTES, stream) != hipSuccess) { fprintf(stderr, "memset failed\n"); return; }
    Params p{};
    for (int i = 0; i < 20; ++i) p.in[i] = (const float*)d_in[i];
    p.out = (float*)d_out; p.ws = (unsigned char*)d_ws;
#if N_LAUNCH_MODE == 1
    p.ph_lo = 0; p.ph_hi = N_PHASES;
    { void* args[] = {&p}; hipError_t e = hipLaunchCooperativeKernel((const void*)hybrid_fwd, dim3(grid), dim3(NTHR), args, LDS_BYTES, stream);
      if (e != hipSuccess) fprintf(stderr, "cooperative launch failed: %s\n", hipGetErrorString(e)); }
#else
    for (int ph = 0; ph < N_PHASES; ++ph) { p.ph_lo = ph; p.ph_hi = ph + 1; void* args[] = {&p};
        hipError_t e = hipLaunchCooperativeKernel((const void*)hybrid_fwd, dim3(grid), dim3(NTHR), args, LDS_BYTES, stream);
        if (e != hipSuccess) { fprintf(stderr, "launch %d failed: %s\n", ph, hipGetErrorString(e)); break; } }
#endif
}
```
